# Optimizing an MI355X kernel written in HIP

```python
import jax, jax.numpy as jnp
from jax import lax
import numpy as np

D_MODEL = 1024
BATCH = 8
SEQ = 4096
DEPTH = 2

D_MIX = D_MODEL
LRU_WIDTH = D_MIX // 2
GMLP_WIDTH = D_MIX - LRU_WIDTH
LRU_HEADS = 8
LRU_HEAD_DIM = LRU_WIDTH // LRU_HEADS
GMLP_HEADS = 8
GMLP_HEAD_DIM = GMLP_WIDTH // GMLP_HEADS
CONV_WIDTH = 4
RG_LRU_C = 8.0
CHUNK = 128
D_FF = ((8 * D_MODEL // 3 + 127) // 128) * 128
N_MOD = 9
IN_COLS = 2 * LRU_WIDTH + 2 * GMLP_WIDTH
EPS = 1e-6

kernel_name = "hybrid_rglru_gmlp_macaron_adaln"


def rms_norm(x, g):
    x32 = x.astype(jnp.float32)
    y = x32 * lax.rsqrt(jnp.mean(x32 * x32, axis=-1, keepdims=True) + EPS)
    return (y * g.astype(jnp.float32)).astype(x.dtype)


def layer_norm(x, g):
    x32 = x.astype(jnp.float32)
    mu = jnp.mean(x32, axis=-1, keepdims=True)
    var = jnp.mean(jnp.square(x32 - mu), axis=-1, keepdims=True)
    return ((x32 - mu) * lax.rsqrt(var + EPS) * g.astype(jnp.float32)).astype(x.dtype)


def modulate(h, shift, scale):
    return h * (1.0 + scale) + shift


def swiglu(h, w_gu, w_down):
    g, u = jnp.split(h @ w_gu, 2, axis=-1)
    return (jax.nn.silu(g) * u) @ w_down


def causal_depthwise_conv(x, w, b):
    S = x.shape[1]
    xp = jnp.pad(x, ((0, 0), (CONV_WIDTH - 1, 0), (0, 0)))
    y = b
    for k in range(CONV_WIDTH):
        y = y + xp[:, k:k + S] * w[k]
    return y


def _lin_rec_combine(left, right):
    a1, b1 = left
    a2, b2 = right
    return a1 * a2, a2 * b1 + b2


def rg_lru(xb, wa, ba, wx, bx, lam):
    B, S, _ = xb.shape
    xh = xb.reshape(B, S, LRU_HEADS, LRU_HEAD_DIM)
    r = jax.nn.sigmoid(jnp.einsum('bshd,hde->bshe', xh, wa) + ba).reshape(B, S, LRU_WIDTH)
    i = jax.nn.sigmoid(jnp.einsum('bshd,hde->bshe', xh, wx) + bx).reshape(B, S, LRU_WIDTH)
    log_a = RG_LRU_C * r.astype(jnp.float32) * jax.nn.log_sigmoid(lam.astype(jnp.float32))
    a = jnp.exp(log_a)
    mult = jnp.sqrt(-jnp.expm1(2.0 * log_a))
    inp = mult * (i * xb).astype(jnp.float32)
    _, h = lax.associative_scan(_lin_rec_combine, (a, inp), axis=1)
    return h.astype(xb.dtype)


def chunked_gmlp(u, v, v_norm, spatial_w, spatial_b):
    B, S, _ = u.shape
    nc = S // CHUNK
    u = jax.nn.gelu(u)
    v = jax.nn.gelu(v)
    vh = v.reshape(B, nc, CHUNK, GMLP_HEADS, GMLP_HEAD_DIM)
    vh = layer_norm(vh, v_norm.reshape(GMLP_HEADS, GMLP_HEAD_DIM))
    mask = jnp.tril(jnp.ones((CHUNK, CHUNK), dtype=spatial_w.dtype))
    ws = spatial_w * mask
    z = jnp.einsum('hts,bnshd->bnthd', ws, vh) + spatial_b.T[:, :, None]
    return u * z.reshape(B, S, GMLP_WIDTH)


def setup_inputs(seed: int = 0) -> dict:
    key = jax.random.key(seed)
    ks = jax.random.split(key, 32)
    f32 = jnp.float32
    L, D = DEPTH, D_MODEL

    def nrm(k, shape, scale):
        return jax.random.normal(k, shape, f32) * scale

    def gain(k, shape):
        return 1.0 + 0.05 * jax.random.normal(k, shape, f32)

    a0 = jax.random.uniform(ks[12], (L, LRU_WIDTH), f32, minval=0.9, maxval=0.999)
    lru_lambda = jnp.log(a0) - jnp.log1p(-a0)
    return {
        'x': jax.random.normal(ks[0], (BATCH, SEQ, D), f32),
        'c': jax.random.normal(ks[1], (BATCH, D), f32),
        'w_ada': nrm(ks[2], (L, D, N_MOD * D), 0.5 * D ** -0.5),
        'b_ada': nrm(ks[3], (L, N_MOD * D), 0.02),
        'ffn1_norm': gain(ks[4], (L, D)),
        'ffn1_w_gu': nrm(ks[5], (L, D, 2 * D_FF), D ** -0.5),
        'ffn1_w_down': nrm(ks[6], (L, D_FF, D), D_FF ** -0.5),
        'mix_norm': gain(ks[7], (L, D)),
        'w_in': nrm(ks[8], (L, D, IN_COLS), D ** -0.5),
        'conv_w': nrm(ks[9], (L, CONV_WIDTH, LRU_WIDTH), CONV_WIDTH ** -0.5),
        'conv_b': nrm(ks[10], (L, LRU_WIDTH), 0.02),
        'gate_a_w': nrm(ks[11], (L, LRU_HEADS, LRU_HEAD_DIM, LRU_HEAD_DIM), LRU_HEAD_DIM ** -0.5),
        'gate_a_b': nrm(ks[13], (L, LRU_HEADS, LRU_HEAD_DIM), 0.02),
        'gate_x_w': nrm(ks[14], (L, LRU_HEADS, LRU_HEAD_DIM, LRU_HEAD_DIM), LRU_HEAD_DIM ** -0.5),
        'gate_x_b': nrm(ks[15], (L, LRU_HEADS, LRU_HEAD_DIM), 0.02),
        'lru_lambda': lru_lambda,
        'v_norm': gain(ks[16], (L, GMLP_WIDTH)),
        'spatial_w': nrm(ks[17], (L, GMLP_HEADS, CHUNK, CHUNK), CHUNK ** -0.5),
        'spatial_b': nrm(ks[18], (L, GMLP_HEADS, CHUNK), 0.02),
        'lru_out_norm': gain(ks[19], (L, LRU_WIDTH)),
        'gmlp_out_norm': gain(ks[20], (L, GMLP_WIDTH)),
        'w_out': nrm(ks[21], (L, D_MIX, D), D_MIX ** -0.5),
        'ffn2_norm': gain(ks[22], (L, D)),
        'ffn2_w_gu': nrm(ks[23], (L, D, 2 * D_FF), D ** -0.5),
        'ffn2_w_down': nrm(ks[24], (L, D_FF, D), D_FF ** -0.5),
        'final_norm': gain(ks[25], (D,)),
    }


def reference(x, c, w_ada, b_ada, ffn1_norm, ffn1_w_gu, ffn1_w_down, mix_norm, w_in,
              conv_w, conv_b, gate_a_w, gate_a_b, gate_x_w, gate_x_b, lru_lambda,
              v_norm, spatial_w, spatial_b, lru_out_norm, gmlp_out_norm, w_out,
              ffn2_norm, ffn2_w_gu, ffn2_w_down, final_norm):
    B = x.shape[0]
    sc = jax.nn.silu(c)
    for l in range(DEPTH):
        mod = (sc @ w_ada[l] + b_ada[l]).reshape(B, N_MOD, 1, D_MODEL)

        h = modulate(rms_norm(x, ffn1_norm[l]), mod[:, 0], mod[:, 1])
        x = x + 0.5 * mod[:, 2] * swiglu(h, ffn1_w_gu[l], ffn1_w_down[l])

        h = modulate(rms_norm(x, mix_norm[l]), mod[:, 3], mod[:, 4])
        proj = h @ w_in[l]
        x_lru, g_lru, u, v = jnp.split(
            proj, [LRU_WIDTH, 2 * LRU_WIDTH, 2 * LRU_WIDTH + GMLP_WIDTH], axis=-1)
        x_lru = causal_depthwise_conv(x_lru, conv_w[l], conv_b[l])
        y_lru = rg_lru(x_lru, gate_a_w[l], gate_a_b[l], gate_x_w[l], gate_x_b[l],
                       lru_lambda[l]) * jax.nn.gelu(g_lru)
        y_gmlp = chunked_gmlp(u, v, v_norm[l], spatial_w[l], spatial_b[l])
        y = jnp.concatenate([rms_norm(y_lru, lru_out_norm[l]),
                             rms_norm(y_gmlp, gmlp_out_norm[l])], axis=-1)
        x = x + mod[:, 5] * (y @ w_out[l])

        h = modulate(rms_norm(x, ffn2_norm[l]), mod[:, 6], mod[:, 7])
        x = x + 0.5 * mod[:, 8] * swiglu(h, ffn2_w_gu[l], ffn2_w_down[l])
    return rms_norm(x, final_norm)
```

```cpp
#include <hip/hip_runtime.h>
#include <hip/hip_cooperative_groups.h>
#include <cstdio>
#include <cstdint>
namespace cg = cooperative_groups;

#ifndef DUP_PHASE
#define DUP_PHASE 0
#endif
#define REPS(k) _Pragma("unroll 1") for (int rep_ = 0; rep_ < ((DUP_PHASE == (k)) ? 2 : 1); ++rep_)
#ifndef MK_N_LAUNCHES
#define MK_N_LAUNCHES 1
#endif

constexpr int DM = 1024, NB = 8, SEQ = 4096, DEPTH = 2, M = NB * SEQ;
constexpr int DFF = 2816, NGU = 2 * DFF, NIN = 2048, LW = 512, NMOD = 9 * DM;
constexpr float EPS = 1e-6f;

#define LAS __attribute__((address_space(3)))
#define GAS __attribute__((address_space(1)))
typedef unsigned short bf16;
typedef short bf16x8 __attribute__((ext_vector_type(8)));
typedef float f32x4 __attribute__((ext_vector_type(4)));
typedef float f32x16 __attribute__((ext_vector_type(16)));
typedef unsigned u32x4 __attribute__((ext_vector_type(4)));
typedef unsigned u32x2 __attribute__((ext_vector_type(2)));
typedef float f32x2 __attribute__((ext_vector_type(2)));
typedef _Float16 f16x4 __attribute__((ext_vector_type(4)));

#define LDS_WAIT() asm volatile("s_waitcnt lgkmcnt(0)" ::: "memory")
#define VM_WAIT() asm volatile("s_waitcnt vmcnt(0)" ::: "memory")

__device__ __forceinline__ float bf2f(unsigned v) { return __uint_as_float(v << 16); }
__device__ __forceinline__ unsigned f2bf(float f) { unsigned u = __float_as_uint(f); return (u + 0x7fffu + ((u >> 16) & 1u)) >> 16; }
__device__ __forceinline__ unsigned pk2(float lo, float hi) { unsigned r; asm("v_cvt_pk_bf16_f32 %0, %1, %2" : "=v"(r) : "v"(lo), "v"(hi)); return r; }
__device__ __forceinline__ unsigned f2bf_hw(float f) { return pk2(f, f); }
__device__ __forceinline__ float fast_sigmoid(float x) { return __builtin_amdgcn_rcpf(1.0f + __builtin_amdgcn_exp2f(x * -1.4426950408889634f)); }
__device__ __forceinline__ float gelu_tanh(float x) { const float x2 = x * x; const float t = x * __builtin_fmaf(x2, -0.10294324f, -2.3022082f);
    return x * __builtin_amdgcn_rcpf(1.0f + __builtin_amdgcn_exp2f(t)); }
__device__ __forceinline__ float silu_f(float x) { return x * fast_sigmoid(x); }
__device__ __forceinline__ float nexpm1(float x) {
    const float p = x * (1.f + x * (0.5f + x * (0.16666667f + x * (0.041666668f + x * 0.008333334f))));
    const float e = 1.f - __expf(x);
    return (x > -0.25f) ? -p : e;
}
__device__ __forceinline__ int lane_id() { return (int)__builtin_amdgcn_mbcnt_hi(~0u, __builtin_amdgcn_mbcnt_lo(~0u, 0u)); }
__device__ __forceinline__ int lane_id_v() { int x; asm volatile("v_mbcnt_lo_u32_b32 %0, -1, 0\n\tv_mbcnt_hi_u32_b32 %0, -1, %0" : "=v"(x)); return x; }
#define GET_TID(tidvar) int tidvar; asm volatile("v_mbcnt_lo_u32_b32 %0, -1, 0\n\tv_mbcnt_hi_u32_b32 %0, -1, %0\n\tv_lshl_add_u32 %0, %1, 6, %0" : "=&v"(tidvar) : "s"(WV))
template <int MASK> __device__ __forceinline__ float shx(float v) {
    if constexpr (MASK < 32) return __int_as_float(__builtin_amdgcn_ds_swizzle(__float_as_int(v), (MASK << 10) | 0x1f));
    else { const int idx = (lane_id_v() ^ 32) << 2; return __int_as_float(__builtin_amdgcn_ds_bpermute(idx, __float_as_int(v))); }
}
__device__ __forceinline__ float wave_sum(float v) { v += shx<1>(v); v += shx<2>(v); v += shx<4>(v); v += shx<8>(v); v += shx<16>(v); v += shx<32>(v); return v; }


#define XB_TMO      128
#define XB_XCNT(j)  (256  + 64 * (j))
#define XB_XSUB(j)  (1280 + 64 * (j))
#define XB_XGEN(j)  (2304 + 64 * (j))
#define XB_TOP      3328
#define XB_TOPGEN   3392
#define XCD_BAR_WORDS 3456
#define XB_SPIN_CAP (1u << 22)
__device__ __forceinline__ unsigned xb_ld(unsigned* p)              { return __hip_atomic_load(p, __ATOMIC_RELAXED, __HIP_MEMORY_SCOPE_AGENT); }
__device__ __forceinline__ unsigned xb_add(unsigned* p, unsigned v) { return __hip_atomic_fetch_add(p, v, __ATOMIC_RELAXED, __HIP_MEMORY_SCOPE_AGENT); }
__device__ __forceinline__ unsigned xb_xcc_id() { return (unsigned)__builtin_amdgcn_readfirstlane((int)(__builtin_amdgcn_s_getreg((3 << 11) | 20) & 0xFu)); }
#define XB_SPIN(cond, bar) do { unsigned _sp = 0; while (cond) { __builtin_amdgcn_s_sleep(1); \
    if ((++_sp & 255u) == 0u) { if (xb_ld(&(bar)[XB_TMO])) break; if (_sp > XB_SPIN_CAP) { atomicAdd(&(bar)[XB_TMO], 1u); break; } } } } while (0)
struct XcdBarrier { unsigned* bar; unsigned x; volatile LAS unsigned* st; };
__device__ __forceinline__ XcdBarrier xcd_barrier_post(unsigned* bar, volatile LAS unsigned* st, bool t0) {
    XcdBarrier b; b.bar = bar; b.x = xb_xcc_id(); b.st = st;
    if (t0) (void)xb_add(&bar[XB_XCNT(b.x)], 1u);
    return b;
}
__device__ __forceinline__ void xcd_barrier_complete(unsigned* bar, unsigned x, unsigned& nloc, unsigned& nx) {
    const unsigned G = gridDim.x * gridDim.y * gridDim.z;
    unsigned sum, cnt, mine, sp = 0u;
    for (;;) {
        sum = 0u; cnt = 0u; mine = 0u;
#pragma unroll
        for (unsigned j = 0; j < 16; ++j) { const unsigned c = xb_ld(&bar[XB_XCNT(j)]); sum += c; cnt += (c > 0u) ? 1u : 0u; mine = (j == x) ? c : mine; }
        if (sum == G) break;
        __builtin_amdgcn_s_sleep(1);
        if ((++sp & 255u) == 0u) { if (xb_ld(&bar[XB_TMO])) break; if (sp > XB_SPIN_CAP) { atomicAdd(&bar[XB_TMO], 1u); break; } }
    }
    nloc = mine > 0u ? mine : 1u; nx = cnt > 0u ? cnt : 1u;
}
__device__ __forceinline__ void xcd_barrier(const XcdBarrier& b, bool t0) {
    asm volatile("s_waitcnt vmcnt(0)" ::: "memory");
    __syncthreads();
    if (t0) {
        GAS unsigned* barg_ = (GAS unsigned*)b.bar; unsigned bx = b.x; asm volatile("" : "+s"(barg_), "+s"(bx)); unsigned* bar = (unsigned*)barg_;
        __builtin_amdgcn_s_waitcnt(0);
        unsigned nloc = b.st[0], nx = b.st[1];
        if (nloc == 0u) { xcd_barrier_complete(bar, bx, nloc, nx); b.st[0] = nloc; b.st[1] = nx; }
        const unsigned old = xb_add(&bar[XB_XSUB(bx)], 1u);
        const unsigned gen = old / nloc;
        if (old + 1u == (gen + 1u) * nloc) {
            __builtin_amdgcn_fence(__ATOMIC_RELEASE, "agent");
            asm volatile("s_waitcnt vmcnt(0)" ::: "memory");
            const unsigned og = xb_add(&bar[XB_TOP], 1u);
            const unsigned tg = og / nx;
            if (og + 1u == (tg + 1u) * nx) xb_add(&bar[XB_TOPGEN], 1u);
            else XB_SPIN(xb_ld(&bar[XB_TOPGEN]) == tg, bar);
            __builtin_amdgcn_fence(__ATOMIC_ACQUIRE, "agent");
            xb_add(&bar[XB_XGEN(bx)], 1u);
            asm volatile("s_waitcnt vmcnt(0)" ::: "memory");
        } else {
            XB_SPIN(xb_ld(&bar[XB_XGEN(bx)]) == gen, bar);
            __builtin_amdgcn_fence(__ATOMIC_ACQUIRE, "agent");
            asm volatile("s_waitcnt vmcnt(0)" ::: "memory");
        }
    }
    __syncthreads();
}

namespace pg8 {
#define PG8_LAS __attribute__((address_space(3)))
typedef unsigned short bf16_t;
constexpr int BM = 256, BK = 64, HALF = 128, HTB = HALF * BK * 2, STAGE_BYTES = 8 * HTB, NXCD = 8, WGM = 8;

__host__ __device__ __forceinline__ int lds_byte(int r, int c) { const int st = (r >> 4) * 2 + (c >> 5), rr = r & 15, cc = c & 31, ob = rr * 64 + cc * 2; return st * 1024 + (ob ^ (((ob >> 9) & 1) << 5)); }
__host__ __device__ __forceinline__ void stage_rc(int b, int& R, int& C) { const int st = b / 1024, sb = b % 1024, swz = sb ^ (((sb >> 9) & 1) << 5); R = (st >> 1) * 16 + swz / 64; C = (st & 1) * 32 + (swz % 64) / 2; }
__host__ __device__ __forceinline__ int perm32(int rho) { const int n = rho >> 4, i = rho & 15; return 8 * (i >> 2) + 4 * n + (i & 3); }

template <int N> __device__ __forceinline__ void pg8_wait_v() { asm volatile("s_waitcnt vmcnt(%0)" :: "n"(N) : "memory"); }
constexpr int EPI_OFF = STAGE_BYTES;
__host__ __device__ __forceinline__ size_t wtile_off(int R, int k, int NT) {
    const int c32 = R & 31, rho = 16 * ((c32 >> 2) & 1) + 4 * (c32 >> 3) + (c32 & 3), S = (R & ~31) | rho;
    return (size_t)((R >> 8) * NT + (k >> 6)) * (BM * BK) + (size_t)(((S & 255) >> 7) * 8192 + ((((S & 127) >> 4) * 2 + ((k & 63) >> 5)) * 512) + (S & 15) * 32 + (k & 31));
}
struct Unit { int pm, pn; };
struct Gemm { const bf16_t* A; const bf16_t* Bt; int M, N, K; bool atiled; };

struct StaticOrder {
    int nM, nN, nwg, G, c;
    __host__ __device__ void init(int M_, int N_, int G_, int c_) { nM = M_ / BM; nN = N_ / BM; nwg = nM * nN; G = G_; c = c_; }
    __host__ __device__ bool next(int i, Unit& u) const {
        const long L = (long)i * G + c; if (L >= nwg) return false;
        int wgid = (int)L; { const int q = nwg / NXCD, r = nwg % NXCD, xcd = wgid % NXCD, off = wgid / NXCD; wgid = (xcd < r ? xcd * (q + 1) : r * (q + 1) + (xcd - r) * q) + off; }
        const int nig = WGM * nN, gid = wgid / nig, fm = gid * WGM, gsz = (nM - fm) < WGM ? (nM - fm) : WGM;
        u.pm = fm + ((wgid % nig) % gsz); u.pn = (wgid % nig) / gsz; return true;
    }
    __device__ __forceinline__ void a_ready(const Unit&) const {}
    __device__ __forceinline__ void done(const Unit&) const {}
};

__device__ __forceinline__ unsigned cvt_pk_bf16(float lo, float hi) { unsigned r; asm volatile("v_cvt_pk_bf16_f32 %0, %1, %2" : "=v"(r) : "v"(lo), "v"(hi)); return r; }

struct EpiBf16 {
    static constexpr bool PERM = true, AFTER_DRAIN = false;
    bf16_t* O; int ldc; const float* rss; const float* sw;
    __device__ __forceinline__ const float* src0(const Unit& u) const { return rss + u.pm * BM; }
    __device__ __forceinline__ const float* src1(const Unit& u) const { return sw + (size_t)(u.pm >> 4) * 5632 + u.pn * BM; }
    __device__ __forceinline__ void operator()(const f32x4 (&acc)[2][2][4][2], const Unit& u, int wr, int wc, int fr, int fq, const PG8_LAS float* ep) const {
        const int row0 = u.pm * BM + wr * 64 + fr; const int col0 = u.pn * BM + wc * 32 + 8 * fq;
        f32x4 sv[2][2]; float rs[2][4];
#pragma unroll
        for (int bj = 0; bj < 2; ++bj)
#pragma unroll
            for (int n = 0; n < 2; ++n) sv[bj][n] = *(const PG8_LAS f32x4*)(ep + 256 + wc * 32 + 8 * fq + bj * HALF + 4 * n);
#pragma unroll
        for (int ai = 0; ai < 2; ++ai)
#pragma unroll
            for (int m = 0; m < 4; ++m) rs[ai][m] = ep[wr * 64 + fr + ai * HALF + m * 16];
#pragma unroll
        for (int ai = 0; ai < 2; ++ai)
#pragma unroll
            for (int m = 0; m < 4; ++m) { bf16_t* rowp = O + (size_t)(u.pm * (NIN / BK) + 4 * u.pn + (wc >> 1)) * (BM * BK) + ai * 8192 + ((wr * 4 + m) * 2 + (wc & 1)) * 512 + fr * 32 + 8 * fq;
                const float rstd = __builtin_amdgcn_rsqf(rs[ai][m] * (1.f / DM) + EPS);
#pragma unroll
                for (int bj = 0; bj < 2; ++bj) { const f32x4 v0 = acc[ai][bj][m][0] * rstd + sv[bj][0], v1 = acc[ai][bj][m][1] * rstd + sv[bj][1];
                    u32x4 w; w.x = cvt_pk_bf16(v0[0], v0[1]); w.y = cvt_pk_bf16(v0[2], v0[3]); w.z = cvt_pk_bf16(v1[0], v1[1]); w.w = cvt_pk_bf16(v1[2], v1[3]);
                    *(u32x4*)(rowp + (size_t)(2 * bj) * BM * BK) = w; } }
    }
};
struct EpiSwiglu {
    static constexpr bool PERM = true, AFTER_DRAIN = false;
    bf16_t* O; int ldc; const float* rss; const float* sw;
    __device__ __forceinline__ const float* src0(const Unit& u) const { return rss + u.pm * BM; }
    __device__ __forceinline__ const float* src1(const Unit& u) const { return sw + (size_t)(u.pm >> 4) * 5632 + u.pn * BM; }
    __device__ __forceinline__ void operator()(const f32x4 (&acc)[2][2][4][2], const Unit& u, int wr, int wc, int fr, int fq, const PG8_LAS float* ep) const {
        const int row0 = u.pm * BM + wr * 64 + fr;
        bf16_t* ob = O + (size_t)(u.pm * (DFF / BK) + 2 * u.pn + (wc >> 1)) * (BM * BK) + ((wr * 4) * 2 + (wc & 1)) * 512 + fr * 32 + 8 * fq;
        f32x4 sv[2][2]; float rs[2][4];
#pragma unroll
        for (int bj = 0; bj < 2; ++bj)
#pragma unroll
            for (int n = 0; n < 2; ++n) sv[bj][n] = *(const PG8_LAS f32x4*)(ep + 256 + wc * 32 + 8 * fq + bj * HALF + 4 * n);
#pragma unroll
        for (int ai = 0; ai < 2; ++ai)
#pragma unroll
            for (int m = 0; m < 4; ++m) rs[ai][m] = ep[wr * 64 + fr + ai * HALF + m * 16];
#pragma unroll
        for (int ai = 0; ai < 2; ++ai)
#pragma unroll
            for (int m = 0; m < 4; ++m) { bf16_t* rowp = ob + ai * 8192 + m * 1024;
                const float rstd = __builtin_amdgcn_rsqf(rs[ai][m] * (1.f / DM) + EPS);
                float h[8];
#pragma unroll
                for (int n = 0; n < 2; ++n)
#pragma unroll
                    for (int e = 0; e < 4; ++e) { const float g = acc[ai][0][m][n][e] * rstd + sv[0][n][e], uu = acc[ai][1][m][n][e] * rstd + sv[1][n][e]; h[4 * n + e] = silu_f(g) * uu; }
                u32x4 w; w.x = cvt_pk_bf16(h[0], h[1]); w.y = cvt_pk_bf16(h[2], h[3]); w.z = cvt_pk_bf16(h[4], h[5]); w.w = cvt_pk_bf16(h[6], h[7]);
                *(u32x4*)rowp = w; }
    }
};
struct EpiResid {
    static constexpr bool PERM = true, AFTER_DRAIN = false;
    _Float16* X; const float* gate; bf16_t* XS; const float* gsn; float* rssn; float coef; int write_xs;
    __device__ __forceinline__ const float* src0(const Unit& u) const { return gate + (size_t)(u.pm >> 4) * NMOD + u.pn * BM; }
    __device__ __forceinline__ const float* src1(const Unit& u) const { return gsn + (u.pm >> 4) * DM + u.pn * BM; }
    __device__ __forceinline__ void operator()(const f32x4 (&acc)[2][2][4][2], const Unit& u, int wr, int wc, int fr, int fq, const PG8_LAS float* ep) const {
        typedef _Float16 f16x8 __attribute__((ext_vector_type(8)));
        const int col0 = u.pn * BM + wc * 32 + 8 * fq;
        f32x4 gv[2][2];
#pragma unroll
        for (int bj = 0; bj < 2; ++bj)
#pragma unroll
            for (int n = 0; n < 2; ++n) gv[bj][n] = *(const PG8_LAS f32x4*)(ep + wc * 32 + 8 * fq + bj * HALF + 4 * n);
        const PG8_LAS float* gsp = ep + 256 + wc * 32 + 8 * fq;
        bf16_t* xsb = XS + (size_t)(u.pm * (DM / BK) + 4 * u.pn + (wc >> 1)) * (BM * BK) + ((wr * 4) * 2 + (wc & 1)) * 512 + fr * 32 + 8 * fq;
        _Float16* xb = X + (size_t)u.pm * (BM * DM) + (size_t)(((u.pn * 8 + wc) * 16 + wr * 4) * 512) + fr * 32 + 8 * fq;
#pragma unroll
        for (int ai = 0; ai < 2; ++ai) {
            f16x8 xin[4][2];
#pragma unroll
            for (int m = 0; m < 4; ++m)
#pragma unroll
                for (int bj = 0; bj < 2; ++bj) xin[m][bj] = *(const f16x8*)(xb + bj * 32768 + ai * 4096 + m * 512);
            asm volatile("" ::: "memory");
            if (ai == 0) {
#pragma unroll
                for (int bj = 0; bj < 2; ++bj)
#pragma unroll
                    for (int n = 0; n < 2; ++n) gv[bj][n] = gv[bj][n] * coef; }
            float ssm = 0.f;
#pragma unroll
            for (int m = 0; m < 4; ++m) { const int row = u.pm * BM + ai * HALF + wr * 64 + m * 16 + fr; const size_t off = (size_t)row * DM + col0;
                float ss = 0.f;
#pragma unroll
                for (int bj = 0; bj < 2; ++bj) {
                    const f16x8 xi = xin[m][bj];
                    const f32x4 x0 = __builtin_convertvector(__builtin_shufflevector(xi, xi, 0, 1, 2, 3), f32x4), x1 = __builtin_convertvector(__builtin_shufflevector(xi, xi, 4, 5, 6, 7), f32x4);
                    const f32x4 o0 = x0 + acc[ai][bj][m][0] * gv[bj][0], o1 = x1 + acc[ai][bj][m][1] * gv[bj][1];
                    const f16x4 h0 = __builtin_convertvector(o0, f16x4), h1 = __builtin_convertvector(o1, f16x4);
                    *(f16x8*)(xb + bj * 32768 + ai * 4096 + m * 512) = __builtin_shufflevector(h0, h1, 0, 1, 2, 3, 4, 5, 6, 7);
                    ss += ((o0[0] * o0[0] + o0[1] * o0[1]) + (o0[2] * o0[2] + o0[3] * o0[3])) + ((o1[0] * o1[0] + o1[1] * o1[1]) + (o1[2] * o1[2] + o1[3] * o1[3]));
                    const f32x4 s0 = o0 * *(const PG8_LAS f32x4*)(gsp + bj * HALF), s1 = o1 * *(const PG8_LAS f32x4*)(gsp + bj * HALF + 4);
                    u32x4 w; w.x = cvt_pk_bf16(s0[0], s0[1]); w.y = cvt_pk_bf16(s0[2], s0[3]); w.z = cvt_pk_bf16(s1[0], s1[1]); w.w = cvt_pk_bf16(s1[2], s1[3]);
                    if (write_xs) *(u32x4*)(xsb + (size_t)(2 * bj) * BM * BK + ai * 8192 + m * 1024) = w; }
                ss += shx<16>(ss); ss += shx<32>(ss);
                if (fq == m) ssm = ss; }
            (void)__hip_atomic_fetch_add(rssn + (u.pm * BM + ai * HALF + wr * 64 + fq * 16 + fr), ssm, __ATOMIC_RELAXED, __HIP_MEMORY_SCOPE_AGENT);
            asm volatile("" ::: "memory");
        }
    }
};

template <class Epi, class Sched, bool ALIGN_EPI = false, bool SP2 = false>
__device__ __forceinline__ void gemm_phase(PG8_LAS unsigned char* lds, const Gemm g, const Sched& S, const Epi& E, const int WV) {
    GET_TID(tid);
    const int wid = WV, lane = tid & 63, wr = wid >> 2, wc = wid & 3, fr = lane & 15, fq = lane >> 4;
    const int K = g.K, nt = K / BK;
    unsigned voffA[2], voffB[2];
#pragma unroll
    for (int i = 0; i < 2; ++i) { int R, C; stage_rc(tid * 16 + i * 8192, R, C); const int Rb = Epi::PERM ? ((R & ~31) + perm32(R & 31)) : R;
        voffA[i] = g.atiled ? (unsigned)(((R >> 4) * 2 + (C >> 5)) * 1024 + (R & 15) * 64 + (C & 31) * 2) : (unsigned)(R * K + C) * 2u;
        voffB[i] = (unsigned)(((R >> 4) * 2 + (C >> 5)) * 1024 + (R & 15) * 64 + (C & 31) * 2); (void)Rb; }
    static_assert(Epi::PERM, "the stored weight layout carries the perm32 row order");
    const size_t kB = (size_t)BM * BK * 2, hB = (size_t)HALF * BK * 2, tB = (size_t)nt * BM * BK * 2;
    const size_t kA = g.atiled ? (size_t)BM * BK * 2 : (size_t)(BK * 2), hA = g.atiled ? (size_t)HALF * BK * 2 : (size_t)HALF * K * 2, tA = g.atiled ? (size_t)nt * BM * BK * 2 : (size_t)BM * K * 2;


    const unsigned ldsw = (unsigned)wid * 1024u;
    const int aoff = lds_byte(wr * 64 + fr, fq * 8), boff = lds_byte(wc * 32 + fr, fq * 8);
#define PG8_SA(b, h) (((b) * 2 + (h)) * HTB)
#define PG8_SB(b, h) ((4 + (b) * 2 + (h)) * HTB)
#define PG8_STAGE(bufoff, gbase, voff) do { _Pragma("unroll") for (int _i = 0; _i < 2; ++_i) \
        __builtin_amdgcn_global_load_lds((const unsigned*)((const char*)(gbase) + (voff)[_i]), (PG8_LAS unsigned*)(lds + (bufoff) + ldsw + _i * 8192), 16, 0, 0); } while (0)
#define PG8_LDA(dst, b, h) do { _Pragma("unroll") for (int m = 0; m < 4; ++m) _Pragma("unroll") for (int k = 0; k < 2; ++k) dst[m][k] = *(const PG8_LAS bf16x8*)(lds + PG8_SA(b, h) + aoff + m * 2048 + k * 1024); } while (0)
#define PG8_LDB(dst, b, h) do { _Pragma("unroll") for (int n = 0; n < 2; ++n) _Pragma("unroll") for (int k = 0; k < 2; ++k) dst[n][k] = *(const PG8_LAS bf16x8*)(lds + PG8_SB(b, h) + boff + n * 2048 + k * 1024); } while (0)
#define PG8_MMA(ai, bj, At, Bt) do { __builtin_amdgcn_s_setprio(1); _Pragma("unroll") for (int m = 0; m < 4; ++m) _Pragma("unroll") for (int n = 0; n < 2; ++n) _Pragma("unroll") for (int k = 0; k < 2; ++k) \
        acc[ai][bj][m][n] = __builtin_amdgcn_mfma_f32_16x16x32_bf16(Bt[n][k], At[m][k], acc[ai][bj][m][n], 0, 0, 0); __builtin_amdgcn_s_setprio(0); } while (0)
#define PG8_WAIT_V(n) asm volatile("s_waitcnt vmcnt(" #n ")" ::: "memory")
#define PG8_WAIT_L(n) asm volatile("s_waitcnt lgkmcnt(" #n ")" ::: "memory")
#define PG8_BAR __builtin_amdgcn_s_barrier()
#define PG8_SCHED __builtin_amdgcn_sched_barrier(0)
    Unit cur, nxt; int ui = 0;
    if (!S.next(0, cur)) return;
    f32x4 acc[2][2][4][2];
#pragma unroll
    for (int a = 0; a < 2; ++a)
#pragma unroll
        for (int b = 0; b < 2; ++b)
#pragma unroll
            for (int m = 0; m < 4; ++m)
#pragma unroll
                for (int n = 0; n < 2; ++n) acc[a][b][m][n] = (f32x4){0.f, 0.f, 0.f, 0.f};
    bf16x8 At[4][2], B0[2][2], B1[2][2];
    const char* cA = (const char*)g.A + (size_t)cur.pm * tA; const char* cB = (const char*)g.Bt + (size_t)cur.pn * tB;
    S.a_ready(cur);
    if constexpr (SP2) {
        PG8_STAGE(PG8_SB(0, 0), cB, voffB); PG8_STAGE(PG8_SB(0, 1), cB + hB, voffB); PG8_STAGE(PG8_SA(0, 0), cA, voffA); PG8_STAGE(PG8_SA(0, 1), cA + hA, voffA);
        if (wr == 1) PG8_BAR;
        PG8_WAIT_V(2); PG8_BAR;
        PG8_STAGE(PG8_SB(1, 0), cB + kB, voffB); PG8_STAGE(PG8_SA(1, 0), cA + kA, voffA); PG8_STAGE(PG8_SB(1, 1), cB + hB + kB, voffB);
        PG8_WAIT_V(6); PG8_BAR;
    } else {
        PG8_STAGE(PG8_SB(0, 0), cB, voffB); PG8_STAGE(PG8_SA(0, 0), cA, voffA); PG8_STAGE(PG8_SB(0, 1), cB + hB, voffB); PG8_STAGE(PG8_SA(0, 1), cA + hA, voffA);
        if (wr == 1) PG8_BAR;
        PG8_WAIT_V(4); PG8_BAR;
        PG8_STAGE(PG8_SB(1, 0), cB + kB, voffB); PG8_STAGE(PG8_SA(1, 0), cA + kA, voffA); PG8_STAGE(PG8_SB(1, 1), cB + hB + kB, voffB);
        PG8_WAIT_V(6); PG8_BAR;
    }
    for (;;) {
        const bool has_next = S.next(ui + 1, nxt);
        const char* nA = has_next ? (const char*)g.A + (size_t)nxt.pm * tA : cA; const char* nB = has_next ? (const char*)g.Bt + (size_t)nxt.pn * tB : cB;
        for (int t = 0; t < nt; t += 2) {
            const bool last = (t == nt - 2);
            const char* a1 = cA + (size_t)(t + 1) * kA;
            const char* a2 = last ? nA : cA + (size_t)(t + 2) * kA; const char* b2 = last ? nB : cB + (size_t)(t + 2) * kB;
            const char* a3 = a2 + kA; const char* b3 = b2 + kB;
            if (last && has_next) S.a_ready(nxt);
            if constexpr (SP2) {
            { const float* es_ = (wid < 4 ? E.src0(cur) + wid * 64 : E.src1(cur) + (wid - 4) * 64) + lane; const unsigned eo_ = EPI_OFF + (last ? 0u : 2048u) + wid * 256;
            PG8_LDB(B0, 0, 0); PG8_LDB(B1, 0, 1); PG8_SCHED; PG8_LDA(At, 0, 0); PG8_STAGE(PG8_SA(1, 1), a1 + hA, voffA);
            __builtin_amdgcn_global_load_lds((const unsigned*)es_, (PG8_LAS unsigned*)(lds + eo_), 4, 0, 0); }
            PG8_WAIT_V(9); PG8_WAIT_L(0); PG8_BAR; PG8_MMA(0, 0, At, B0); PG8_MMA(0, 1, At, B1); PG8_BAR; PG8_SCHED;
            PG8_LDA(At, 0, 1); PG8_STAGE(PG8_SB(0, 0), b2, voffB); PG8_STAGE(PG8_SB(0, 1), b2 + hB, voffB); PG8_STAGE(PG8_SA(0, 0), a2, voffA);
            PG8_WAIT_V(9); PG8_WAIT_L(0); PG8_BAR; PG8_MMA(1, 0, At, B0); PG8_MMA(1, 1, At, B1); PG8_BAR; PG8_SCHED;
            PG8_LDB(B0, 1, 0); PG8_LDB(B1, 1, 1); PG8_SCHED; PG8_LDA(At, 1, 0); PG8_STAGE(PG8_SA(0, 1), a2 + hA, voffA);
            PG8_WAIT_V(9); PG8_WAIT_L(0); PG8_BAR; PG8_MMA(0, 0, At, B0); PG8_MMA(0, 1, At, B1); PG8_BAR; PG8_SCHED;
            PG8_LDA(At, 1, 1); PG8_STAGE(PG8_SB(1, 0), b3, voffB); PG8_STAGE(PG8_SB(1, 1), b3 + hB, voffB); PG8_STAGE(PG8_SA(1, 0), a3, voffA);
            PG8_WAIT_V(8); PG8_WAIT_L(0); PG8_BAR; PG8_MMA(1, 0, At, B0); PG8_MMA(1, 1, At, B1); PG8_BAR; PG8_SCHED;
            } else {
            PG8_LDB(B0, 0, 0); PG8_SCHED; PG8_LDA(At, 0, 0); PG8_STAGE(PG8_SA(1, 1), a1 + hA, voffA);
            PG8_WAIT_L(8); PG8_BAR; PG8_WAIT_L(0); PG8_MMA(0, 0, At, B0); PG8_BAR; PG8_SCHED;
            PG8_LDB(B1, 0, 1); PG8_STAGE(PG8_SB(0, 0), b2, voffB);
            PG8_BAR; PG8_WAIT_L(0); PG8_MMA(0, 1, At, B1); PG8_BAR;
            PG8_LDA(At, 0, 1); PG8_STAGE(PG8_SA(0, 0), a2, voffA);
            PG8_BAR; PG8_WAIT_L(0); PG8_MMA(1, 0, At, B0); PG8_BAR; PG8_SCHED;
            PG8_STAGE(PG8_SB(0, 1), b2 + hB, voffB);
            PG8_WAIT_V(6); PG8_BAR; PG8_MMA(1, 1, At, B1); PG8_BAR;
            PG8_LDB(B0, 1, 0); PG8_SCHED; PG8_LDA(At, 1, 0); PG8_STAGE(PG8_SA(0, 1), a2 + hA, voffA);
            PG8_WAIT_L(8); PG8_BAR; PG8_WAIT_L(0); PG8_MMA(0, 0, At, B0); PG8_BAR; PG8_SCHED;
            PG8_LDB(B1, 1, 1); PG8_STAGE(PG8_SB(1, 0), b3, voffB);
            PG8_BAR; PG8_WAIT_L(0); PG8_MMA(0, 1, At, B1); PG8_BAR;
            PG8_LDA(At, 1, 1); PG8_STAGE(PG8_SA(1, 0), a3, voffA);
            PG8_BAR; PG8_WAIT_L(0); PG8_MMA(1, 0, At, B0); PG8_BAR; PG8_SCHED;
            PG8_STAGE(PG8_SB(1, 1), b3 + hB, voffB);
            PG8_WAIT_V(6); PG8_BAR; PG8_MMA(1, 1, At, B1); PG8_BAR;
            }
        }
        if constexpr (ALIGN_EPI) { if (wr == 0) PG8_BAR; }
        if constexpr (!Epi::AFTER_DRAIN) { E(acc, cur, wr, wc, fr, fq, (const PG8_LAS float*)(lds + EPI_OFF)); S.done(cur); }
        if (!has_next) break;
#pragma unroll
        for (int a = 0; a < 2; ++a)
#pragma unroll
            for (int b = 0; b < 2; ++b)
#pragma unroll
                for (int m = 0; m < 4; ++m)
#pragma unroll
                    for (int n = 0; n < 2; ++n) acc[a][b][m][n] = (f32x4){0.f, 0.f, 0.f, 0.f};
        cur = nxt; cA = nA; cB = nB; ++ui;
        if constexpr (ALIGN_EPI) { if (wr == 1) PG8_BAR; }
    }
    PG8_WAIT_V(0);
    if constexpr (!ALIGN_EPI) { if (wr == 0) PG8_BAR; }
    PG8_BAR;
#undef PG8_SA
#undef PG8_SB
#undef PG8_STAGE
#undef PG8_LDA
#undef PG8_LDB
#undef PG8_MMA
#undef PG8_WAIT_V
#undef PG8_WAIT_L
#undef PG8_BAR
#undef PG8_SCHED
}
}

constexpr size_t MiB = 1u << 20;
constexpr size_t WS_RSS = 65536;
constexpr size_t WS_ZERO_BYTES = 1 * MiB;
constexpr size_t WS_MOD = 1 * MiB;
constexpr size_t WS_GS = 1 * MiB + 640 * 1024;
constexpr size_t WS_SW = 5 * MiB;
constexpr size_t WS_GWT = 2 * MiB;
constexpr size_t WS_SPW = 3 * MiB;
constexpr size_t WS_AGG = 4 * MiB;
constexpr size_t WS_W = 8 * MiB;
constexpr size_t WL_GU1 = 0, WL_DOWN1 = 11 * MiB, WL_WIN = WL_DOWN1 + 5 * MiB + MiB / 2, WL_WOUT = WL_WIN + 4 * MiB, WL_GU2 = WL_WOUT + 2 * MiB, WL_DOWN2 = WL_GU2 + 11 * MiB, WL_SIZE = 39 * MiB;
constexpr size_t WS_H = 88 * MiB;
constexpr size_t WS_ACT = 152 * MiB;
constexpr size_t WS_Y = 328 * MiB;
constexpr size_t WS_X16 = 392 * MiB;
constexpr size_t WS_END = 456 * MiB;
static_assert(WL_DOWN2 + 5 * MiB + MiB / 2 == WL_SIZE && WS_W + 2 * WL_SIZE <= WS_H, "ws map");

constexpr int LDS_MISC_OFF = 143360;
constexpr int LDS_BYTES = 147456;
constexpr int NWAVES = 8;

struct Args { const float* in[26]; float* out; unsigned char* ws; int lo, hi; };
#define AIN(i) ((const float*)(((const GAS float* const volatile __attribute__((address_space(4)))*)__builtin_amdgcn_kernarg_segment_ptr())[i]))
enum { I_X = 0, I_C, I_WADA, I_BADA, I_F1N, I_F1GU, I_F1D, I_MIXN, I_WIN, I_CONVW, I_CONVB, I_GAW, I_GAB, I_GXW, I_GXB, I_LAM, I_VN, I_SPW, I_SPB, I_LON, I_GON, I_WOUT, I_F2N, I_F2GU, I_F2D, I_FIN };

__device__ __forceinline__ void transpose_item(const float* W, int K, int N, bf16* WT, int mode, LAS float* scr, int item, int lane) {
    const int nblk = N / 32, kb = item / nblk, nb = item % nblk, k0 = 64 * kb, n0 = 32 * nb;
    int drow0 = n0;
    if (mode == 1) { const int j = n0 < DFF ? n0 : n0 - DFF; drow0 = 256 * (j >> 7) + (j & 127) + (n0 < DFF ? 0 : 128); }
#pragma unroll
    for (int i = 0; i < 8; ++i) { const int kk = 8 * i + (lane >> 3), n4 = 4 * (lane & 7); const f32x4 w4 = *(const f32x4*)(W + (size_t)(k0 + kk) * N + n0 + n4);
        LAS float* d_ = scr + kk * 33 + n4; d_[0] = w4.x; d_[1] = w4.y; d_[2] = w4.z; d_[3] = w4.w; }
    LDS_WAIT();
    const int srow = lane >> 2, cc = lane & 3;
#pragma unroll
    for (int j = 0; j < 4; ++j) { const int rg = j >> 1, kh = j & 1, n = pg8::perm32(16 * rg + srow), c = kh * 4 + cc; const LAS float* s = scr + (8 * c) * 33 + n;
        u32x4 o; o.x = pk2(s[0 * 33], s[1 * 33]); o.y = pk2(s[2 * 33], s[3 * 33]); o.z = pk2(s[4 * 33], s[5 * 33]); o.w = pk2(s[6 * 33], s[7 * 33]);
        *(u32x4*)(WT + pg8::wtile_off(drow0 + n, k0 + 8 * c, K / 64)) = o; }
    LDS_WAIT();
}

__device__ __forceinline__ void p0_phase(const Args& a, LAS unsigned char* lds, int G, const int WV) {
    GET_TID(tid);
    const int lane = tid & 63, wave = WV;
    GAS unsigned char* wsg_ = (GAS unsigned char*)a.ws; asm volatile("" : "+s"(wsg_)); unsigned char* ws = (unsigned char*)wsg_;
    {
        LAS float* scL = (LAS float*)lds;
        LAS float* red = (LAS float*)(lds + 32768);
        for (int i = tid; i < NB * DM; i += 512) { const int b = i >> 10, k = i & 1023; scL[k * 8 + b] = silu_f(AIN(I_C)[i]); }
        __syncthreads();
        float* mod = (float*)(ws + WS_MOD);
        for (int item = blockIdx.x; item < DEPTH * (NMOD / 64); item += G) {
            const int l = item / (NMOD / 64), grp = item % (NMOD / 64), n = 64 * grp + lane;
            const float* W = AIN(I_WADA) + (size_t)l * DM * NMOD + n;
            float acc[8];
#pragma unroll
            for (int b = 0; b < 8; ++b) acc[b] = 0.f;
#pragma unroll 16
            for (int kk = 0; kk < 128; ++kk) { const int k = 128 * wave + kk; const float w = W[(size_t)k * NMOD];
                const f32x4 s0 = *(const LAS f32x4*)(scL + k * 8), s1 = *(const LAS f32x4*)(scL + k * 8 + 4);
                acc[0] += w * s0[0]; acc[1] += w * s0[1]; acc[2] += w * s0[2]; acc[3] += w * s0[3];
                acc[4] += w * s1[0]; acc[5] += w * s1[1]; acc[6] += w * s1[2]; acc[7] += w * s1[3]; }
#pragma unroll
            for (int b = 0; b < 8; ++b) red[(wave * 8 + b) * 64 + lane] = acc[b];
            __syncthreads();
            { const int b = wave; float s = 0.f;
#pragma unroll
              for (int w = 0; w < 8; ++w) s += red[(w * 8 + b) * 64 + lane];
              mod[(size_t)(l * 8 + b) * NMOD + n] = s + AIN(I_BADA)[(size_t)l * NMOD + n]; }
            __syncthreads();
        }
    }
    {
        const int gt = blockIdx.x * 512 + tid, NT = G * 512;
        bf16* gwt = (bf16*)(ws + WS_GWT);
        for (int i = gt; i < DEPTH * 2 * 8 * 64 * 64; i += NT) {
            const int d = i & 63, e = (i >> 6) & 63, h = (i >> 12) & 7, g = (i >> 15) & 1, l = i >> 16;
            const float* src = g ? AIN(I_GXW) : AIN(I_GAW);
            gwt[i] = (bf16)f2bf(src[(((size_t)l * 8 + h) * 64 + d) * 64 + e]);
        }
        bf16* spw = (bf16*)(ws + WS_SPW);
        for (int i = gt; i < DEPTH * 8 * 128 * 128; i += NT) { const int s = i & 127, t = (i >> 7) & 127; spw[i] = (s <= t) ? (bf16)f2bf(AIN(I_SPW)[i]) : (bf16)0; }
    }
    {
        LAS float* scr = (LAS float*)(lds + wave * 16384);
        const int gw = blockIdx.x * NWAVES + wave, NGW = G * NWAVES;
        constexpr int I_GU = (DM / 64) * (NGU / 32), I_DN = (DFF / 64) * (DM / 32), I_IN = (DM / 64) * (NIN / 32), I_OUT = (DM / 64) * (DM / 32);
        constexpr int PER_L = 2 * I_GU + 2 * I_DN + I_IN + I_OUT;
        for (int it = gw; it < DEPTH * PER_L; it += NGW) {
            const int l = it / PER_L; int r = it % PER_L;
            unsigned char* wl = ws + WS_W + (size_t)l * WL_SIZE;
            if (r < I_GU) { transpose_item(AIN(I_F1GU) + (size_t)l * DM * NGU, DM, NGU, (bf16*)(wl + WL_GU1), 1, scr, r, lane); continue; } r -= I_GU;
            if (r < I_GU) { transpose_item(AIN(I_F2GU) + (size_t)l * DM * NGU, DM, NGU, (bf16*)(wl + WL_GU2), 1, scr, r, lane); continue; } r -= I_GU;
            if (r < I_DN) { transpose_item(AIN(I_F1D) + (size_t)l * DFF * DM, DFF, DM, (bf16*)(wl + WL_DOWN1), 0, scr, r, lane); continue; } r -= I_DN;
            if (r < I_DN) { transpose_item(AIN(I_F2D) + (size_t)l * DFF * DM, DFF, DM, (bf16*)(wl + WL_DOWN2), 0, scr, r, lane); continue; } r -= I_DN;
            if (r < I_IN) { transpose_item(AIN(I_WIN) + (size_t)l * DM * NIN, DM, NIN, (bf16*)(wl + WL_WIN), 0, scr, r, lane); continue; } r -= I_IN;
            transpose_item(AIN(I_WOUT) + (size_t)l * DM * DM, DM, DM, (bf16*)(wl + WL_WOUT), 0, scr, r, lane);
        }
    }
}

__device__ __forceinline__ void norm0_phase(const float* Xin, _Float16* Xcopy, const float* gain, const float* scale, bf16* XS, float* rss, int G, const int WV) {
    GET_TID(tid_);
    const int lane = tid_ & 63, wave = tid_ >> 6, gw = blockIdx.x * NWAVES + wave, NGW = G * NWAVES, fr = lane & 15, fq = lane >> 4;
    for (int rgi = gw; rgi < M / 16; rgi += NGW) {
        const int m = rgi * 16 + fr, b = m >> 12;
        const float* xr = Xin + (size_t)m * DM + 8 * fq; const float* gp = gain + 8 * fq; const float* sc = scale + (size_t)b * NMOD + 8 * fq;
        _Float16* xc = Xcopy + (size_t)(m >> 8) * (256 * DM) + (size_t)(((m & 255) >> 4) * 512) + fr * 32 + 8 * fq;
        bf16* xst = XS + (size_t)(m >> 8) * (16 * 16384) + ((m & 255) >> 7) * 8192 + (((m & 127) >> 4) * 2) * 512 + fr * 32 + 8 * fq;
        float s = 0.f;
#pragma unroll 4
        for (int cg = 0; cg < 32; ++cg) {
            const f32x4 v0 = *(const f32x4*)(xr + cg * 32), v1 = *(const f32x4*)(xr + cg * 32 + 4);
            const f32x4 g0 = *(const f32x4*)(gp + cg * 32), g1 = *(const f32x4*)(gp + cg * 32 + 4), c0 = *(const f32x4*)(sc + cg * 32), c1 = *(const f32x4*)(sc + cg * 32 + 4);
            s += ((v0.x * v0.x + v0.y * v0.y) + (v0.z * v0.z + v0.w * v0.w)) + ((v1.x * v1.x + v1.y * v1.y) + (v1.z * v1.z + v1.w * v1.w));
            typedef _Float16 f16x8 __attribute__((ext_vector_type(8)));
            const f16x4 h0 = __builtin_convertvector(v0, f16x4), h1 = __builtin_convertvector(v1, f16x4);
            *(f16x8*)(xc + (size_t)cg * 16 * 512) = __builtin_shufflevector(h0, h1, 0, 1, 2, 3, 4, 5, 6, 7);
            const f32x4 o0 = v0 * g0 * (c0 + 1.0f), o1 = v1 * g1 * (c1 + 1.0f);
            u32x4 w; w.x = pk2(o0.x, o0.y); w.y = pk2(o0.z, o0.w); w.z = pk2(o1.x, o1.y); w.w = pk2(o1.z, o1.w);
            *(u32x4*)(xst + (size_t)(cg >> 1) * 16384 + (cg & 1) * 512) = w;
        }
        s += shx<16>(s); s += shx<32>(s);
        if (fq == 0) rss[m] = s;
    }
}
__device__ __forceinline__ void prep_phase(const Args& a, LAS unsigned char* lds, int G, const int WV) {
    GET_TID(tid);
    const int lane = tid & 63, wave = WV;
    GAS unsigned char* wsg_ = (GAS unsigned char*)a.ws; asm volatile("" : "+s"(wsg_)); unsigned char* ws = (unsigned char*)wsg_;
    const float* mod = (const float*)(ws + WS_MOD);
    float* GS = (float*)(ws + WS_GS); float* SW = (float*)(ws + WS_SW);
    const int gt = blockIdx.x * 512 + tid, NT = G * 512;
    for (int i = gt; i < DEPTH * 3 * NB * DM; i += NT) { const int col = i & 1023, b = (i >> 10) & 7, ls = i >> 13, l = ls / 3, sub = ls % 3;
        const float gain = (sub == 0 ? AIN(I_F1N) : sub == 1 ? AIN(I_MIXN) : AIN(I_F2N))[l * DM + col];
        GS[i] = gain * (1.0f + mod[((size_t)(l * 8 + b) * 9 + 3 * sub + 1) * DM + col]); }
    LAS float* shL = (LAS float*)lds;
    const int gw = blockIdx.x * NWAVES + wave, NGW = G * NWAVES;
    for (int ls = 0; ls < DEPTH * 3; ++ls) {
        const int l = ls / 3, sub = ls % 3;
        __syncthreads();
        for (int i = tid; i < NB * DM; i += 512) { const int b = i >> 10, k = i & 1023; shL[i] = mod[((size_t)(l * 8 + b) * 9 + 3 * sub) * DM + k]; }
        __syncthreads();
        const bf16* Wt = (const bf16*)(ws + WS_W + (size_t)l * WL_SIZE + (sub == 0 ? WL_GU1 : sub == 1 ? WL_WIN : WL_GU2));
        const int nrows = (sub == 1) ? NIN : NGU;
        float* swb = SW + (size_t)ls * NB * 5632;
        for (int row = gw; row < nrows; row += NGW) {
            const u32x4 w0 = *(const u32x4*)(Wt + pg8::wtile_off(row, lane * 16, DM / 64)), w1 = *(const u32x4*)(Wt + pg8::wtile_off(row, lane * 16 + 8, DM / 64));
            float wf[16];
#pragma unroll
            for (int j = 0; j < 4; ++j) { wf[2 * j] = bf2f(w0[j] & 0xffffu); wf[2 * j + 1] = __uint_as_float(w0[j] & 0xffff0000u); wf[8 + 2 * j] = bf2f(w1[j] & 0xffffu); wf[8 + 2 * j + 1] = __uint_as_float(w1[j] & 0xffff0000u); }
#pragma unroll
            for (int b = 0; b < 8; ++b) { const LAS f32x4* sp = (const LAS f32x4*)(shL + b * DM + lane * 16); float sacc = 0.f;
#pragma unroll
                for (int q = 0; q < 4; ++q) { const f32x4 sv = sp[q]; sacc += wf[4 * q] * sv[0] + wf[4 * q + 1] * sv[1] + wf[4 * q + 2] * sv[2] + wf[4 * q + 3] * sv[3]; }
                sacc = wave_sum(sacc);
                if (lane == 0) swb[b * 5632 + row] = sacc; }
        }
    }
}
__device__ __forceinline__ void final_phase(const _Float16* X, float* out, const float* gain, const float* rss, int G, const int WV) {
    GET_TID(tid_);
    const int lane = tid_ & 63, wave = tid_ >> 6, gw = blockIdx.x * NWAVES + wave, NGW = G * NWAVES;
    for (int m = gw; m < M; m += NGW) {
        const _Float16* xr = X + (size_t)(m >> 8) * (256 * DM) + (size_t)(((lane >> 3) * 16 + ((m & 255) >> 4)) * 512) + (m & 15) * 32 + 4 * (lane & 7);
        f32x4* orow = (f32x4*)(out + (size_t)m * DM) + lane;
        const float rstd = __builtin_amdgcn_rsqf(rss[m] * (1.f / DM) + EPS);
        const f32x4* gp = (const f32x4*)gain + lane;
#pragma unroll
        for (int j = 0; j < 4; ++j) orow[64 * j] = __builtin_convertvector(*(const f16x4*)(xr + (size_t)(8 * j) * 16 * 512), f32x4) * rstd * gp[64 * j];
    }
}

#define MFMA32(a, b, c) __builtin_amdgcn_mfma_f32_32x32x16_bf16((a), (b), (c), 0, 0, 0)
__device__ __forceinline__ int crow(int reg, int h) { return (reg & 3) + 8 * (reg >> 2) + 4 * h; }

constexpr int M1_WAVE_LDS = 17408, M1_PART_OFF = 8 * M1_WAVE_LDS;

typedef _Float16 f16x2 __attribute__((ext_vector_type(2)));
template <bool FINAL>
__device__ __forceinline__ void lru_pass(const Args& a, LAS unsigned char* lds, int l, int item, int tid, int h) {
    GAS unsigned char* wsg_ = (GAS unsigned char*)a.ws; asm volatile("" : "+s"(wsg_)); unsigned char* ws = (unsigned char*)wsg_;
    const bf16* PROJ = (const bf16*)(ws + WS_ACT);
    bf16* Y = (bf16*)(ws + WS_Y);
    float* AGG = (float*)(ws + WS_AGG);
    unsigned* LI = (unsigned*)(ws + WS_H);
    const bf16* GWT = (const bf16*)(ws + WS_GWT);
    LAS unsigned char* wl = lds + h * M1_WAVE_LDS;
    LAS unsigned short* xcL = (LAS unsigned short*)wl;
    LAS float* xcF = (LAS float*)(wl + 4608);
    LAS float* part = (LAS float*)(lds + M1_PART_OFF);
    const int c = item & 31; const size_t r0 = (size_t)item * 128;
    unsigned lane = tid & 63; asm volatile("" : "+v"(lane));
    const unsigned r = lane & 31, hh = lane >> 5;
    const int chb = 64 * h;
    const bf16* Pu = PROJ + (size_t)(item >> 1) * (32 * 16384) + (size_t)h * 16384 + (item & 1) * 8192;
    const unsigned lo_x = (lane >> 5) * 512 + (lane & 31);
    float w0 = 0.f, w1 = 0.f, w2 = 0.f, w3 = 0.f, cb = 0.f, xm3 = 0.f, xm2 = 0.f, xm1 = 0.f;
    float ba_[2], bx_[2], c8[2], Arun[2], Hrun[2], lon[2];
#pragma unroll
    for (int nb = 0; nb < 2; ++nb) { ba_[nb] = 0.f; bx_[nb] = 0.f; c8[nb] = 0.f; Arun[nb] = 1.f; Hrun[nb] = 0.f; lon[nb] = 0.f; }
    if constexpr (!FINAL) {
        w0 = (AIN(I_CONVW) + (l * 4 + 0) * LW + chb)[lane]; w1 = (AIN(I_CONVW) + (l * 4 + 1) * LW + chb)[lane]; w2 = (AIN(I_CONVW) + (l * 4 + 2) * LW + chb)[lane]; w3 = (AIN(I_CONVW) + (l * 4 + 3) * LW + chb)[lane];
        cb = (AIN(I_CONVB) + l * LW + chb)[lane];
        if (c > 0) { const bf16* Pp = PROJ + (size_t)((item - 1) >> 1) * (32 * 16384) + (size_t)h * 16384 + ((item - 1) & 1) * 8192 + (7 * 2) * 512;
            xm3 = bf2f((Pp + 13 * 32)[lo_x]); xm2 = bf2f((Pp + 14 * 32)[lo_x]); xm1 = bf2f((Pp + 15 * 32)[lo_x]); }
#pragma unroll
        for (int nb = 0; nb < 2; ++nb) { ba_[nb] = (AIN(I_GAB) + (l * 8 + h) * 64 + 32 * nb)[r]; bx_[nb] = (AIN(I_GXB) + (l * 8 + h) * 64 + 32 * nb)[r];
            const float lam = (AIN(I_LAM) + l * LW + chb + 32 * nb)[r]; c8[nb] = -8.0f * 1.4426950408889634f * log1pf(expf(-lam));
            ba_[nb] *= -1.4426950408889634f; bx_[nb] *= -1.4426950408889634f; }
    } else {
        const int b = item >> 5;
#pragma unroll
        for (int nb = 0; nb < 2; ++nb) { lon[nb] = (AIN(I_LON) + l * LW + chb + 32 * nb)[r];
            f32x2 ag[31]; const f32x2* agb = (const f32x2*)(AGG + ((size_t)(b * 32) * LW + chb + 32 * nb) * 2);
#pragma unroll
            for (int cc = 0; cc < 31; ++cc) ag[cc] = (agb + cc * LW)[r];
            float hc = 0.f;
#pragma unroll
            for (int cc = 0; cc < 31; ++cc) hc = (cc < c) ? ag[cc].x * hc + ag[cc].y : hc;
            Hrun[nb] = hc; }
    }
#pragma unroll 1
    for (int tb = 0; tb < 4; ++tb) {
        unsigned ln = lane; asm volatile("" : "+v"(ln));
        const unsigned r_ = ln & 31, hh_ = ln >> 5;
        const bf16* Pt = Pu + (size_t)(4 * tb) * 512;
        u32x4* liq = (u32x4*)LI + ((r0 + 32 * tb) >> 2) * LW + chb;
        const unsigned lo_l = hh_ * LW + r_;
        float y[2][16];
        if constexpr (!FINAL) {
            bf16x8 Bg[2][2][4];
            { const bf16* gb = GWT + ((size_t)(l * 2) * 8 + h) * 4096; const unsigned go = r_ * 64 + 8 * hh_;
#pragma unroll
              for (int g = 0; g < 2; ++g)
#pragma unroll
                for (int nb = 0; nb < 2; ++nb)
#pragma unroll
                    for (int kk = 0; kk < 4; ++kk) Bg[g][nb][kk] = *(const bf16x8*)(gb + g * 8 * 4096 + 32 * nb * 64 + 16 * kk + go); }
            unsigned short xraw[32];
#pragma unroll
            for (int t = 0; t < 32; ++t) xraw[t] = (Pt + ((t >> 4) * 2) * 512 + (t & 15) * 32)[(ln >> 5) * 512 + (ln & 31)];
#pragma unroll
            for (int t = 0; t < 32; ++t) {
                const float xv = bf2f(xraw[t]);
                float xc = cb + w0 * xm3; xc += w1 * xm2; xc += w2 * xm1; xc += w3 * xv;
                xm3 = xm2; xm2 = xm1; xm1 = xv;
                xcL[t * 72 + ln] = (unsigned short)f2bf_hw(xc); xcF[t * 64 + ln] = xc;
            }
            LDS_WAIT();
            bf16x8 Af[4];
            { const LAS unsigned short* xa = xcL + r_ * 72 + 8 * hh_;
#pragma unroll
              for (int kk = 0; kk < 4; ++kk) Af[kk] = *(const LAS bf16x8*)(xa + 16 * kk); }
            const LAS float* xcFb = xcF + hh_ * 256 + r_;
#pragma unroll
            for (int nb = 0; nb < 2; ++nb) {
                f32x16 accA, accX;
#pragma unroll
                for (int i = 0; i < 16; ++i) { accA[i] = 0.f; accX[i] = 0.f; }
#pragma unroll
                for (int kk = 0; kk < 4; ++kk) { accA = MFMA32(Af[kk], Bg[0][nb][kk], accA); accX = MFMA32(Af[kk], Bg[1][nb][kk], accX); }
#pragma unroll
                for (int g = 0; g < 4; ++g) {
                    float As = 1.f, Hs = 0.f; u32x4 pk4;
#pragma unroll
                    for (int q = 0; q < 4; ++q) { const int v = 4 * g + q, tc = 8 * g + q;
                        const float rr = __builtin_amdgcn_rcpf(1.0f + __builtin_amdgcn_exp2f(__builtin_fmaf(accA[v], -1.4426950408889634f, ba_[nb]))), ii = __builtin_amdgcn_rcpf(1.0f + __builtin_amdgcn_exp2f(__builtin_fmaf(accX[v], -1.4426950408889634f, bx_[nb])));
                        f16x2 pk; pk.x = (_Float16)(c8[nb] * rr);
                        const float la = (float)pk.x, av = __builtin_amdgcn_exp2f(la), mult = __builtin_amdgcn_sqrtf(__builtin_fmaf(-av, av, 1.0f));
                        const float xcv = xcFb[tc * 64 + 32 * nb];
                        pk.y = (_Float16)(mult * (ii * xcv)); const float iv = (float)pk.y;
                        pk4[q] = __builtin_bit_cast(unsigned, pk);
                        Hs = av * Hs + iv; As *= av; }
                    (liq + (2 * g) * LW + 32 * nb)[lo_l] = pk4;
                    const float pA = shx<32>(As), pH = shx<32>(Hs);
                    const float A1 = hh_ ? pA : As, H1 = hh_ ? pH : Hs, A2 = hh_ ? As : pA, H2 = hh_ ? Hs : pH;
                    const float Ac = A1 * A2, Hc = A2 * H1 + H2;
                    Hrun[nb] = Ac * Hrun[nb] + Hc; Arun[nb] *= Ac;
                }
            }
        } else {
            unsigned liraw[2][16]; unsigned short graw[2][16];
            const unsigned lo_g = hh_ * 128 + r_;
#pragma unroll
            for (int nb = 0; nb < 2; ++nb)
#pragma unroll
                for (int g = 0; g < 4; ++g) { const u32x4 t4 = (liq + (2 * g) * LW + 32 * nb)[lo_l]; liraw[nb][4 * g] = t4.x; liraw[nb][4 * g + 1] = t4.y; liraw[nb][4 * g + 2] = t4.z; liraw[nb][4 * g + 3] = t4.w;
#pragma unroll
                    for (int q = 0; q < 4; ++q) { const int v = 4 * g + q, tc = q + 8 * g; graw[nb][v] = (Pt + 8 * 16384 + ((g >> 1) * 2 + nb) * 512 + (8 * (g & 1) + q) * 32)[lo_g]; (void)tc; } }
#pragma unroll
            for (int nb = 0; nb < 2; ++nb)
#pragma unroll
                for (int g = 0; g < 4; ++g) {
                    float As = 1.f, Hs = 0.f, av[4], iv[4];
#pragma unroll
                    for (int q = 0; q < 4; ++q) { const f16x2 pk = __builtin_bit_cast(f16x2, liraw[nb][4 * g + q]); av[q] = __builtin_amdgcn_exp2f((float)pk.x); iv[q] = (float)pk.y; Hs = av[q] * Hs + iv[q]; As *= av[q]; }
                    const float pA = shx<32>(As), pH = shx<32>(Hs);
                    const float A1 = hh_ ? pA : As, H1 = hh_ ? pH : Hs, A2 = hh_ ? As : pA, H2 = hh_ ? Hs : pH;
                    float hcur = hh_ ? (A1 * Hrun[nb] + H1) : Hrun[nb];
#pragma unroll
                    for (int q = 0; q < 4; ++q) { hcur = av[q] * hcur + iv[q]; y[nb][4 * g + q] = hcur * gelu_tanh(bf2f(graw[nb][4 * g + q])); }
                    const float Ac = A1 * A2, Hc = A2 * H1 + H2;
                    Hrun[nb] = Ac * Hrun[nb] + Hc;
                }
            const int pb = tb & 1;
            LAS float* pw = part + pb * 256 + hh_ * 32 + h;
#pragma unroll
            for (int v = 0; v < 16; ++v) { const int tc = (v & 3) + 8 * (v >> 2);
                float ss = y[0][v] * y[0][v] + y[1][v] * y[1][v];
                ss += shx<1>(ss); ss += shx<2>(ss); ss += shx<4>(ss); ss += shx<8>(ss); ss += shx<16>(ss);
                if (r_ == 0) pw[tc * 8] = ss; }
            LDS_WAIT(); __syncthreads();
            bf16* yrow = Y + (size_t)(item >> 1) * (256 * DM) + (size_t)h * 16384 + (item & 1) * 8192 + (4 * tb) * 512;
            const LAS float* pr = part + pb * 256 + hh_ * 32;
            const unsigned lo_y = hh_ * 128 + r_;
#pragma unroll
            for (int v = 0; v < 16; ++v) { const int tc = (v & 3) + 8 * (v >> 2);
                const f32x4 p0 = *(const LAS f32x4*)(pr + tc * 8), p1 = *(const LAS f32x4*)(pr + tc * 8 + 4);
                const float tot = ((p0[0] + p0[1]) + (p0[2] + p0[3])) + ((p1[0] + p1[1]) + (p1[2] + p1[3]));
                const float rstd = __builtin_amdgcn_rsqf(tot * (1.f / LW) + EPS);
                bf16* yp = yrow + ((v >> 3) * 2) * 512 + (8 * ((v >> 2) & 1) + (v & 3)) * 32;
                yp[lo_y] = (bf16)f2bf_hw(y[0][v] * rstd * lon[0]); yp[lo_y + 512] = (bf16)f2bf_hw(y[1][v] * rstd * lon[1]); }
        }
        LDS_WAIT();
    }
    if constexpr (!FINAL) {
        if (hh == 0) {
#pragma unroll
            for (int nb = 0; nb < 2; ++nb) { float* ag = AGG + ((size_t)item * LW + chb + 32 * nb) * 2; f32x2 v2; v2.x = Arun[nb]; v2.y = Hrun[nb]; ((f32x2*)ag)[r] = v2; }
        }
    }
}

__device__ __forceinline__ void mixer1_phase(const Args& a, LAS unsigned char* lds, int l, int G, const int WV) {
    GET_TID(tid);
    const int h = WV;
    GAS unsigned char* wsg_ = (GAS unsigned char*)a.ws; asm volatile("" : "+s"(wsg_)); unsigned char* ws = (unsigned char*)wsg_;
    const bf16* PROJ = (const bf16*)(ws + WS_ACT);
    bf16* Y = (bf16*)(ws + WS_Y);
    const bf16* GWT = (const bf16*)(ws + WS_GWT); const bf16* SPWm = (const bf16*)(ws + WS_SPW);
    LAS unsigned char* wl = lds + h * M1_WAVE_LDS;
    LAS unsigned short* xcL = (LAS unsigned short*)wl;
    LAS float* xcF = (LAS float*)(wl + 4608);
    LAS unsigned short* vhT = (LAS unsigned short*)wl;
    LAS float* part = (LAS float*)(lds + M1_PART_OFF);
    for (int item = blockIdx.x; item < NB * 32; item += G) {
        const int c = item & 31; const size_t r0 = (size_t)item * 128;
        REPS(9) lru_pass<false>(a, lds, l, item, tid, h);
#ifndef M1_NO_GMLP
        {
            unsigned lane = tid & 63; asm volatile("" : "+v"(lane));
            const unsigned r = lane & 31, hh = lane >> 5;
            const bf16* Vu = PROJ + (size_t)(item >> 1) * (32 * 16384) + (size_t)(24 + h) * 16384 + (item & 1) * 8192;
            u32x4 vraw[2][8];
#pragma unroll
            for (int half = 0; half < 2; ++half) { const unsigned s_ = lane + 64 * half; const bf16* vp = Vu + ((s_ >> 4) * 2) * 512 + (s_ & 15) * 32;
#pragma unroll
                for (int i = 0; i < 8; ++i) vraw[half][i] = *(const u32x4*)(vp + (i >> 2) * 512 + (i & 3) * 8); }
#pragma unroll
            for (int half = 0; half < 2; ++half) {
                float vv[64]; float sum = 0.f;
#pragma unroll
                for (int i = 0; i < 8; ++i) { const u32x4 w = vraw[half][i];
#pragma unroll
                    for (int j = 0; j < 4; ++j) { const float lo = gelu_tanh(bf2f(w[j] & 0xffffu)), hi = gelu_tanh(__uint_as_float(w[j] & 0xffff0000u)); vv[8 * i + 2 * j] = lo; vv[8 * i + 2 * j + 1] = hi; sum += lo + hi; } }
                const float mean = sum * (1.f / 64.f); float q = 0.f;
#pragma unroll
                for (int d = 0; d < 64; ++d) { vv[d] -= mean; q += vv[d] * vv[d]; }
                const float rstd = __builtin_amdgcn_rsqf(q * (1.f / 64.f) + EPS);
                LAS unsigned short* vs = vhT + lane + 64 * half;
#pragma unroll
                for (int d = 0; d < 64; ++d) vs[d * 136] = (unsigned short)f2bf_hw(vv[d] * rstd);
            }
            LDS_WAIT();
            const bf16* Wm = SPWm + (size_t)(l * 8 + h) * 128 * 128;
            const float go0 = (AIN(I_GON) + l * LW + 64 * h)[r], go1 = (AIN(I_GON) + l * LW + 64 * h + 32)[r];
            const float vn0 = (AIN(I_VN) + l * LW + 64 * h)[r], vn1 = (AIN(I_VN) + l * LW + 64 * h + 32)[r];
#pragma unroll 1
            for (int mb = 0; mb < 4; ++mb) {
                unsigned ln = lane; asm volatile("" : "+v"(ln));
                const unsigned r_ = ln & 31, hh_ = ln >> 5;
                f32x16 acc0, acc1;
#pragma unroll
                for (int i = 0; i < 16; ++i) { acc0[i] = 0.f; acc1[i] = 0.f; }
                const bf16* urow = PROJ + (size_t)(item >> 1) * (32 * 16384) + (size_t)(16 + h) * 16384 + (item & 1) * 8192 + (4 * mb) * 512;
                const float* sbrow = AIN(I_SPB) + (l * 8 + h) * 128 + 32 * mb;
                const unsigned lo_u = hh_ * 128 + r_, lo_y = hh_ * 128 + r_;
                unsigned short uraw0[16], uraw1[16];
#pragma unroll
                for (int v = 0; v < 16; ++v) { const int tc = (v & 3) + 8 * (v >> 2); const bf16* up = urow + ((v >> 3) * 2) * 512 + (8 * ((v >> 2) & 1) + (v & 3)) * 32; uraw0[v] = up[lo_u]; uraw1[v] = up[lo_u + 512]; (void)tc; }
                { const bf16* wrow = Wm + (32 * mb) * 128; const unsigned wo = r_ * 128 + 8 * hh_; const LAS unsigned short* vb = vhT + r_ * 136 + 8 * hh_;
                  bf16x8 Afs[8];
#pragma unroll
                  for (int ks = 0; ks < 8; ++ks) Afs[ks] = *(const bf16x8*)(wrow + 16 * ks + wo);
#pragma unroll
                  for (int ks = 0; ks < 8; ++ks) {
                    const bf16x8 B0 = *(const LAS bf16x8*)(vb + 16 * ks);
                    const bf16x8 B1 = *(const LAS bf16x8*)(vb + 32 * 136 + 16 * ks);
                    acc0 = MFMA32(Afs[ks], B0, acc0); acc1 = MFMA32(Afs[ks], B1, acc1);
                  } }
                float y0[16], y1[16];
                const int pb = mb & 1;
                LAS float* pw = part + pb * 256 + hh_ * 32 + h;
#pragma unroll
                for (int v = 0; v < 16; ++v) { const int tc = (v & 3) + 8 * (v >> 2);
                    const float sb_lo = sbrow[tc], sb_hi = sbrow[tc + 4]; const float sbv = hh_ ? sb_hi : sb_lo;
                    const float u0 = gelu_tanh(bf2f(uraw0[v])), u1 = gelu_tanh(bf2f(uraw1[v]));
                    y0[v] = u0 * (acc0[v] * vn0 + sbv); y1[v] = u1 * (acc1[v] * vn1 + sbv);
                    float ss = y0[v] * y0[v] + y1[v] * y1[v];
                    ss += shx<1>(ss); ss += shx<2>(ss); ss += shx<4>(ss); ss += shx<8>(ss); ss += shx<16>(ss);
                    if (r_ == 0) pw[tc * 8] = ss; }
                LDS_WAIT(); __syncthreads();
                bf16* yrow = Y + (size_t)(item >> 1) * (256 * DM) + (size_t)(8 + h) * 16384 + (item & 1) * 8192 + (4 * mb) * 512;
                const LAS float* pr = part + pb * 256 + hh_ * 32;
#pragma unroll
                for (int v = 0; v < 16; ++v) { const int tc = (v & 3) + 8 * (v >> 2);
                    const f32x4 p0 = *(const LAS f32x4*)(pr + tc * 8), p1 = *(const LAS f32x4*)(pr + tc * 8 + 4);
                    const float tot = ((p0[0] + p0[1]) + (p0[2] + p0[3])) + ((p1[0] + p1[1]) + (p1[2] + p1[3]));
                    const float rstd = __builtin_amdgcn_rsqf(tot * (1.f / LW) + EPS);
                    bf16* yp = yrow + ((v >> 3) * 2) * 512 + (8 * ((v >> 2) & 1) + (v & 3)) * 32;
                    yp[lo_y] = (bf16)f2bf_hw(y0[v] * rstd * go0); yp[lo_y + 512] = (bf16)f2bf_hw(y1[v] * rstd * go1); }
            }
            LDS_WAIT();
        }
#endif
    }
}

__device__ __forceinline__ void mixer2_phase(const Args& a, LAS unsigned char* lds, int l, int G, const int WV) {
    GET_TID(tid);
    for (int item = blockIdx.x; item < NB * 32; item += G) { lru_pass<true>(a, lds, l, item, tid, WV); __syncthreads(); }
}

__global__ void __launch_bounds__(NWAVES * 64, 2) mk_fwd(Args args) {
    extern __shared__ __attribute__((aligned(16))) unsigned char lds_raw[];
    LAS unsigned char* lds = (LAS unsigned char*)lds_raw;
    cg::grid_group grid = cg::this_grid();
    const int WV = __builtin_amdgcn_readfirstlane(threadIdx.x >> 6);
#if MK_N_LAUNCHES == 1
    const int G = gridDim.x; constexpr int lo = 0, hi = 1 << 20;
#else
    const int G = gridDim.x, lo = args.lo, hi = args.hi;
#endif
    unsigned char* ws0 = args.ws;
    volatile LAS unsigned* bst = (volatile LAS unsigned*)(lds + LDS_MISC_OFF);
#define T0() (WV == 0 && lane_id_v() == 0)
    if (T0()) { bst[0] = 0u; bst[1] = 0u; }
    __syncthreads();
    XcdBarrier xbar = xcd_barrier_post((unsigned*)ws0, bst, T0());
    int ph = 0;
#define ACTIVE() (ph >= lo && ph < hi)
#define SEAM() do { if (ph >= lo && ph + 1 < hi) { if (args.hi == -12345) grid.sync();   else xcd_barrier(xbar, T0()); if (DUP_PHASE == 7) xcd_barrier(xbar, T0()); } ++ph; } while (0)

    #ifndef SKIP_P0
    if (ACTIVE()) REPS(1) { p0_phase(args, lds, G, WV); __syncthreads(); }
#endif
    SEAM();
#define WSPTRS() GAS unsigned char* wsg_ = (GAS unsigned char*)ws0; asm volatile("" : "+s"(wsg_)); unsigned char* ws = (unsigned char*)wsg_; _Float16* X = (_Float16*)(ws + WS_X16); const float* mod = (const float*)(ws + WS_MOD); bf16* H = (bf16*)(ws + WS_H); bf16* ACT = (bf16*)(ws + WS_ACT); \
    float* RSS = (float*)(ws + WS_RSS); const float* GSb = (const float*)(ws + WS_GS); const float* SWb = (const float*)(ws + WS_SW); bf16* Yb = (bf16*)(ws + WS_Y); \
    (void)X; (void)mod; (void)H; (void)ACT; (void)RSS; (void)GSb; (void)SWb; (void)Yb
    if (ACTIVE()) { WSPTRS(); REPS(2) norm0_phase(AIN(I_X), X, AIN(I_F1N), mod + DM, H, RSS, G, WV); prep_phase(args, lds, G, WV); }
    SEAM();
    for (int l = 0; l < DEPTH; ++l) {
        for (int sub = 0; sub < 3; ++sub) {
            int bid = blockIdx.x; asm volatile("" : "+s"(bid));
            WSPTRS();
            const float* modl = mod + (size_t)l * NB * NMOD;
            unsigned char* wl = ws + WS_W + (size_t)l * WL_SIZE;
            const int ls = l * 3 + sub;
            const float* rss_in = RSS + (size_t)ls * M; const float* sw_in = SWb + (size_t)ls * NB * 5632;
            if (sub != 1) {
                if (ACTIVE()) {
                    pg8::Gemm g{H, (const bf16*)(wl + (sub == 0 ? WL_GU1 : WL_GU2)), M, NGU, DM, true}; pg8::StaticOrder S; S.init(M, NGU, G, bid);
                    pg8::EpiSwiglu E{ACT, DFF, rss_in, sw_in};
                    REPS(3) pg8::gemm_phase<pg8::EpiSwiglu, pg8::StaticOrder, true, true>(lds, g, S, E, WV);
                }
                SEAM();
            } else {
                if (ACTIVE()) {
                    pg8::Gemm g{H, (const bf16*)(wl + WL_WIN), M, NIN, DM, true}; pg8::StaticOrder S; S.init(M, NIN, G, bid);
                    pg8::EpiBf16 E{ACT, NIN, rss_in, sw_in};
                    REPS(4) pg8::gemm_phase<pg8::EpiBf16, pg8::StaticOrder, true, true>(lds, g, S, E, WV);
                }
                SEAM();
                if (ACTIVE()) REPS(5) mixer1_phase(args, lds, l, G, WV);
                SEAM();
                if (ACTIVE()) REPS(6) mixer2_phase(args, lds, l, G, WV);
                SEAM();
            }
            if (ACTIVE()) {
                const bf16* Ain = (sub == 1) ? Yb : ACT; const int K = (sub == 1) ? DM : DFF;
                const bf16* Bt = (const bf16*)(wl + (sub == 0 ? WL_DOWN1 : sub == 1 ? WL_WOUT : WL_DOWN2));
                pg8::Gemm g{Ain, Bt, M, DM, K, true}; pg8::StaticOrder S; S.init(M, DM, G, bid);
                const int lsn = (ls + 1 < DEPTH * 3) ? ls + 1 : ls;
                pg8::EpiResid E{X, modl + (3 * sub + 2) * DM, H, GSb + (size_t)lsn * NB * DM, RSS + (size_t)(ls + 1) * M, (sub == 1 ? 1.0f : 0.5f), (ls + 1 < DEPTH * 3) ? 1 : 0};
                pg8::gemm_phase<pg8::EpiResid, pg8::StaticOrder, true, true>(lds, g, S, E, WV);
            }
            SEAM();
        }
    }
    if (ACTIVE()) { WSPTRS(); final_phase(X, args.out, AIN(I_FIN), RSS + (size_t)(DEPTH * 3) * M, G, WV); }
#undef ACTIVE
#undef SEAM
}
constexpr int N_PHASES = 2 + DEPTH * 8 + 1;

extern "C" void kernel_launch(void* const* d_in, const int* in_sizes, int n_in, void* d_out, int out_size, void* d_ws, size_t ws_size, hipStream_t stream) {
    static int grid = 0;
    if (grid == 0) {
        if (n_in != 26 || in_sizes[0] != M * DM || out_size != M * DM || ws_size < WS_END) { fprintf(stderr, "kernel_launch: unexpected shapes (n_in %d, in0 %d, out %d, ws %zu)\n", n_in, n_in > 0 ? in_sizes[0] : -1, out_size, ws_size); grid = -1; return; }
        int dev = 0, cus = 0, per_cu = 0;
        if (hipGetDevice(&dev) != hipSuccess || hipDeviceGetAttribute(&cus, hipDeviceAttributeMultiprocessorCount, dev) != hipSuccess) { grid = -1; return; }
        if (hipFuncSetAttribute((const void*)mk_fwd, hipFuncAttributeMaxDynamicSharedMemorySize, LDS_BYTES) != hipSuccess) { fprintf(stderr, "kernel_launch: hipFuncSetAttribute failed\n"); grid = -1; return; }
        if (hipOccupancyMaxActiveBlocksPerMultiprocessor(&per_cu, (const void*)mk_fwd, NWAVES * 64, LDS_BYTES) != hipSuccess || per_cu < 1) { fprintf(stderr, "kernel_launch: occupancy query says %d\n", per_cu); per_cu = 1; }
        (void)hipGetLastError();
        grid = cus * 1;
    }
    if (grid < 0) return;
    if (hipMemsetAsync(d_ws, 0, WS_ZERO_BYTES, stream) != hipSuccess) { fprintf(stderr, "kernel_launch: memset of the barrier words failed\n"); return; }
    Args a{};
    for (int i = 0; i < 26; ++i) a.in[i] = (const float*)d_in[i];
    a.out = (float*)d_out; a.ws = (unsigned char*)d_ws;
#if MK_N_LAUNCHES == 1
    a.lo = 0; a.hi = N_PHASES;
    void* kargs[] = {&a};
    hipError_t e = hipLaunchCooperativeKernel((const void*)mk_fwd, dim3(grid), dim3(NWAVES * 64), kargs, LDS_BYTES, stream);
    if (e != hipSuccess) fprintf(stderr, "kernel_launch: cooperative launch failed: %s (grid %d)\n", hipGetErrorString(e), grid);
#else
    for (int p = 0; p < N_PHASES; ++p) { a.lo = p; a.hi = p + 1; hipLaunchKernelGGL(mk_fwd, dim3(grid), dim3(NWAVES * 64), LDS_BYTES, stream, a); }
#endif
}
```

```cpp
#include <hip/hip_runtime.h>
#include <hip/hip_cooperative_groups.h>
#include <cstdio>
#include <cstdint>
namespace cg = cooperative_groups;

#ifndef DUP_PHASE
#define DUP_PHASE 0
#endif
#define REPS(k) _Pragma("unroll 1") for (int rep_ = 0; rep_ < ((DUP_PHASE == (k)) ? 2 : 1); ++rep_)
#ifndef MK_N_LAUNCHES
#define MK_N_LAUNCHES 1
#endif

constexpr int DM = 1024, NB = 8, SEQ = 4096, DEPTH = 2, M = NB * SEQ;
constexpr int DFF = 2816, NGU = 2 * DFF, NIN = 2048, LW = 512, NMOD = 9 * DM;
constexpr float EPS = 1e-6f;

#define LAS __attribute__((address_space(3)))
#define GAS __attribute__((address_space(1)))
typedef unsigned short bf16;
typedef short bf16x8 __attribute__((ext_vector_type(8)));
typedef float f32x4 __attribute__((ext_vector_type(4)));
typedef float f32x16 __attribute__((ext_vector_type(16)));
typedef unsigned u32x4 __attribute__((ext_vector_type(4)));
typedef unsigned u32x2 __attribute__((ext_vector_type(2)));
typedef float f32x2 __attribute__((ext_vector_type(2)));
typedef _Float16 f16x4 __attribute__((ext_vector_type(4)));

#define LDS_WAIT() asm volatile("s_waitcnt lgkmcnt(0)" ::: "memory")
#define VM_WAIT() asm volatile("s_waitcnt vmcnt(0)" ::: "memory")

__device__ __forceinline__ float bf2f(unsigned v) { return __uint_as_float(v << 16); }
__device__ __forceinline__ unsigned f2bf(float f) { unsigned u = __float_as_uint(f); return (u + 0x7fffu + ((u >> 16) & 1u)) >> 16; }
__device__ __forceinline__ unsigned pk2(float lo, float hi) { unsigned r; asm("v_cvt_pk_bf16_f32 %0, %1, %2" : "=v"(r) : "v"(lo), "v"(hi)); return r; }
__device__ __forceinline__ unsigned f2bf_hw(float f) { return pk2(f, f); }
__device__ __forceinline__ float fast_sigmoid(float x) { return __builtin_amdgcn_rcpf(1.0f + __builtin_amdgcn_exp2f(x * -1.4426950408889634f)); }
__device__ __forceinline__ float gelu_tanh(float x) { const float x2 = x * x; const float t = x * __builtin_fmaf(x2, -0.10294324f, -2.3022082f);
    return x * __builtin_amdgcn_rcpf(1.0f + __builtin_amdgcn_exp2f(t)); }
__device__ __forceinline__ float silu_f(float x) { return x * fast_sigmoid(x); }
__device__ __forceinline__ float nexpm1(float x) {
    const float p = x * (1.f + x * (0.5f + x * (0.16666667f + x * (0.041666668f + x * 0.008333334f))));
    const float e = 1.f - __expf(x);
    return (x > -0.25f) ? -p : e;
}
__device__ __forceinline__ int lane_id() { return (int)__builtin_amdgcn_mbcnt_hi(~0u, __builtin_amdgcn_mbcnt_lo(~0u, 0u)); }
__device__ __forceinline__ int lane_id_v() { int x; asm volatile("v_mbcnt_lo_u32_b32 %0, -1, 0\n\tv_mbcnt_hi_u32_b32 %0, -1, %0" : "=v"(x)); return x; }
#define GET_TID(tidvar) int tidvar; asm volatile("v_mbcnt_lo_u32_b32 %0, -1, 0\n\tv_mbcnt_hi_u32_b32 %0, -1, %0\n\tv_lshl_add_u32 %0, %1, 6, %0" : "=&v"(tidvar) : "s"(WV))
template <int MASK> __device__ __forceinline__ float shx(float v) {
    if constexpr (MASK < 32) return __int_as_float(__builtin_amdgcn_ds_swizzle(__float_as_int(v), (MASK << 10) | 0x1f));
    else { const int idx = (lane_id_v() ^ 32) << 2; return __int_as_float(__builtin_amdgcn_ds_bpermute(idx, __float_as_int(v))); }
}
__device__ __forceinline__ float wave_sum(float v) { v += shx<1>(v); v += shx<2>(v); v += shx<4>(v); v += shx<8>(v); v += shx<16>(v); v += shx<32>(v); return v; }


#define XB_TMO      128
#define XB_XCNT(j)  (256  + 64 * (j))
#define XB_XSUB(j)  (1280 + 64 * (j))
#define XB_XGEN(j)  (2304 + 64 * (j))
#define XB_TOP      3328
#define XB_TOPGEN   3392
#define XCD_BAR_WORDS 3456
#define XB_SPIN_CAP (1u << 22)
__device__ __forceinline__ unsigned xb_ld(unsigned* p)              { return __hip_atomic_load(p, __ATOMIC_RELAXED, __HIP_MEMORY_SCOPE_AGENT); }
__device__ __forceinline__ unsigned xb_add(unsigned* p, unsigned v) { return __hip_atomic_fetch_add(p, v, __ATOMIC_RELAXED, __HIP_MEMORY_SCOPE_AGENT); }
__device__ __forceinline__ unsigned xb_xcc_id() { return (unsigned)__builtin_amdgcn_readfirstlane((int)(__builtin_amdgcn_s_getreg((3 << 11) | 20) & 0xFu)); }
#define XB_SPIN(cond, bar) do { unsigned _sp = 0; while (cond) { __builtin_amdgcn_s_sleep(1); \
    if ((++_sp & 255u) == 0u) { if (xb_ld(&(bar)[XB_TMO])) break; if (_sp > XB_SPIN_CAP) { atomicAdd(&(bar)[XB_TMO], 1u); break; } } } } while (0)
struct XcdBarrier { unsigned* bar; unsigned x; volatile LAS unsigned* st; };
__device__ __forceinline__ XcdBarrier xcd_barrier_post(unsigned* bar, volatile LAS unsigned* st, bool t0) {
    XcdBarrier b; b.bar = bar; b.x = xb_xcc_id(); b.st = st;
    if (t0) (void)xb_add(&bar[XB_XCNT(b.x)], 1u);
    return b;
}
__device__ __forceinline__ void xcd_barrier_complete(unsigned* bar, unsigned x, unsigned& nloc, unsigned& nx) {
    const unsigned G = gridDim.x * gridDim.y * gridDim.z;
    unsigned sum, cnt, mine, sp = 0u;
    for (;;) {
        sum = 0u; cnt = 0u; mine = 0u;
#pragma unroll
        for (unsigned j = 0; j < 16; ++j) { const unsigned c = xb_ld(&bar[XB_XCNT(j)]); sum += c; cnt += (c > 0u) ? 1u : 0u; mine = (j == x) ? c : mine; }
        if (sum == G) break;
        __builtin_amdgcn_s_sleep(1);
        if ((++sp & 255u) == 0u) { if (xb_ld(&bar[XB_TMO])) break; if (sp > XB_SPIN_CAP) { atomicAdd(&bar[XB_TMO], 1u); break; } }
    }
    nloc = mine > 0u ? mine : 1u; nx = cnt > 0u ? cnt : 1u;
}
__device__ __forceinline__ void xcd_barrier(const XcdBarrier& b, bool t0) {
    asm volatile("s_waitcnt vmcnt(0)" ::: "memory");
    __syncthreads();
    if (t0) {
        GAS unsigned* barg_ = (GAS unsigned*)b.bar; unsigned bx = b.x; asm volatile("" : "+s"(barg_), "+s"(bx)); unsigned* bar = (unsigned*)barg_;
        __builtin_amdgcn_s_waitcnt(0);
        unsigned nloc = b.st[0], nx = b.st[1];
        if (nloc == 0u) { xcd_barrier_complete(bar, bx, nloc, nx); b.st[0] = nloc; b.st[1] = nx; }
        const unsigned old = xb_add(&bar[XB_XSUB(bx)], 1u);
        const unsigned gen = old / nloc;
        if (old + 1u == (gen + 1u) * nloc) {
            __builtin_amdgcn_fence(__ATOMIC_RELEASE, "agent");
            asm volatile("s_waitcnt vmcnt(0)" ::: "memory");
            const unsigned og = xb_add(&bar[XB_TOP], 1u);
            const unsigned tg = og / nx;
            if (og + 1u == (tg + 1u) * nx) xb_add(&bar[XB_TOPGEN], 1u);
            else XB_SPIN(xb_ld(&bar[XB_TOPGEN]) == tg, bar);
            __builtin_amdgcn_fence(__ATOMIC_ACQUIRE, "agent");
            xb_add(&bar[XB_XGEN(bx)], 1u);
            asm volatile("s_waitcnt vmcnt(0)" ::: "memory");
        } else {
            XB_SPIN(xb_ld(&bar[XB_XGEN(bx)]) == gen, bar);
            __builtin_amdgcn_fence(__ATOMIC_ACQUIRE, "agent");
            asm volatile("s_waitcnt vmcnt(0)" ::: "memory");
        }
    }
    __syncthreads();
}

namespace pg8 {
#define PG8_LAS __attribute__((address_space(3)))
typedef unsigned short bf16_t;
constexpr int BM = 256, BK = 64, HALF = 128, HTB = HALF * BK * 2, STAGE_BYTES = 8 * HTB, NXCD = 8, WGM = 8;

__host__ __device__ __forceinline__ int lds_byte(int r, int c) { const int st = (r >> 4) * 2 + (c >> 5), rr = r & 15, cc = c & 31, ob = rr * 64 + cc * 2; return st * 1024 + (ob ^ (((ob >> 9) & 1) << 5)); }
__host__ __device__ __forceinline__ void stage_rc(int b, int& R, int& C) { const int st = b / 1024, sb = b % 1024, swz = sb ^ (((sb >> 9) & 1) << 5); R = (st >> 1) * 16 + swz / 64; C = (st & 1) * 32 + (swz % 64) / 2; }
__host__ __device__ __forceinline__ int perm32(int rho) { const int n = rho >> 4, i = rho & 15; return 8 * (i >> 2) + 4 * n + (i & 3); }

template <int N> __device__ __forceinline__ void pg8_wait_v() { asm volatile("s_waitcnt vmcnt(%0)" :: "n"(N) : "memory"); }
constexpr int EPI_OFF = STAGE_BYTES;
__host__ __device__ __forceinline__ size_t wtile_off(int R, int k, int NT) {
    const int c32 = R & 31, rho = 16 * ((c32 >> 2) & 1) + 4 * (c32 >> 3) + (c32 & 3), S = (R & ~31) | rho;
    return (size_t)((R >> 8) * NT + (k >> 6)) * (BM * BK) + (size_t)(((S & 255) >> 7) * 8192 + ((((S & 127) >> 4) * 2 + ((k & 63) >> 5)) * 512) + (S & 15) * 32 + (k & 31));
}
struct Unit { int pm, pn; };
struct Gemm { const bf16_t* A; const bf16_t* Bt; int M, N, K; bool atiled; };

struct StaticOrder {
    int nM, nN, nwg, G, c;
    __host__ __device__ void init(int M_, int N_, int G_, int c_) { nM = M_ / BM; nN = N_ / BM; nwg = nM * nN; G = G_; c = c_; }
    __host__ __device__ bool next(int i, Unit& u) const {
        const long L = (long)i * G + c; if (L >= nwg) return false;
        int wgid = (int)L; { const int q = nwg / NXCD, r = nwg % NXCD, xcd = wgid % NXCD, off = wgid / NXCD; wgid = (xcd < r ? xcd * (q + 1) : r * (q + 1) + (xcd - r) * q) + off; }
        const int nig = WGM * nN, gid = wgid / nig, fm = gid * WGM, gsz = (nM - fm) < WGM ? (nM - fm) : WGM;
        u.pm = fm + ((wgid % nig) % gsz); u.pn = (wgid % nig) / gsz; return true;
    }
    __device__ __forceinline__ void a_ready(const Unit&) const {}
    __device__ __forceinline__ void done(const Unit&) const {}
};

__device__ __forceinline__ unsigned cvt_pk_bf16(float lo, float hi) { unsigned r; asm volatile("v_cvt_pk_bf16_f32 %0, %1, %2" : "=v"(r) : "v"(lo), "v"(hi)); return r; }

struct EpiBf16 {
    static constexpr bool PERM = true, AFTER_DRAIN = false;
    bf16_t* O; int ldc; const float* rss; const float* sw;
    __device__ __forceinline__ const float* src0(const Unit& u) const { return rss + u.pm * BM; }
    __device__ __forceinline__ const float* src1(const Unit& u) const { return sw + (size_t)(u.pm >> 4) * 5632 + u.pn * BM; }
    __device__ __forceinline__ void operator()(const f32x4 (&acc)[2][2][4][2], const Unit& u, int wr, int wc, int fr, int fq, const PG8_LAS float* ep) const {
        const int row0 = u.pm * BM + wr * 64 + fr; const int col0 = u.pn * BM + wc * 32 + 8 * fq;
        f32x4 sv[2][2]; float rs[2][4];
#pragma unroll
        for (int bj = 0; bj < 2; ++bj)
#pragma unroll
            for (int n = 0; n < 2; ++n) sv[bj][n] = *(const PG8_LAS f32x4*)(ep + 256 + wc * 32 + 8 * fq + bj * HALF + 4 * n);
#pragma unroll
        for (int ai = 0; ai < 2; ++ai)
#pragma unroll
            for (int m = 0; m < 4; ++m) rs[ai][m] = ep[wr * 64 + fr + ai * HALF + m * 16];
#pragma unroll
        for (int ai = 0; ai < 2; ++ai)
#pragma unroll
            for (int m = 0; m < 4; ++m) { bf16_t* rowp = O + (size_t)(u.pm * (NIN / BK) + 4 * u.pn + (wc >> 1)) * (BM * BK) + ai * 8192 + ((wr * 4 + m) * 2 + (wc & 1)) * 512 + fr * 32 + 8 * fq;
                const float rstd = __builtin_amdgcn_rsqf(rs[ai][m] * (1.f / DM) + EPS);
#pragma unroll
                for (int bj = 0; bj < 2; ++bj) { const f32x4 v0 = acc[ai][bj][m][0] * rstd + sv[bj][0], v1 = acc[ai][bj][m][1] * rstd + sv[bj][1];
                    u32x4 w; w.x = cvt_pk_bf16(v0[0], v0[1]); w.y = cvt_pk_bf16(v0[2], v0[3]); w.z = cvt_pk_bf16(v1[0], v1[1]); w.w = cvt_pk_bf16(v1[2], v1[3]);
                    *(u32x4*)(rowp + (size_t)(2 * bj) * BM * BK) = w; } }
    }
};
struct EpiSwiglu {
    static constexpr bool PERM = true, AFTER_DRAIN = false;
    bf16_t* O; int ldc; const float* rss; const float* sw;
    __device__ __forceinline__ const float* src0(const Unit& u) const { return rss + u.pm * BM; }
    __device__ __forceinline__ const float* src1(const Unit& u) const { return sw + (size_t)(u.pm >> 4) * 5632 + u.pn * BM; }
    __device__ __forceinline__ void operator()(const f32x4 (&acc)[2][2][4][2], const Unit& u, int wr, int wc, int fr, int fq, const PG8_LAS float* ep) const {
        const int row0 = u.pm * BM + wr * 64 + fr;
        bf16_t* ob = O + (size_t)(u.pm * (DFF / BK) + 2 * u.pn + (wc >> 1)) * (BM * BK) + ((wr * 4) * 2 + (wc & 1)) * 512 + fr * 32 + 8 * fq;
        f32x4 sv[2][2]; float rs[2][4];
#pragma unroll
        for (int bj = 0; bj < 2; ++bj)
#pragma unroll
            for (int n = 0; n < 2; ++n) sv[bj][n] = *(const PG8_LAS f32x4*)(ep + 256 + wc * 32 + 8 * fq + bj * HALF + 4 * n);
#pragma unroll
        for (int ai = 0; ai < 2; ++ai)
#pragma unroll
            for (int m = 0; m < 4; ++m) rs[ai][m] = ep[wr * 64 + fr + ai * HALF + m * 16];
#pragma unroll
        for (int ai = 0; ai < 2; ++ai)
#pragma unroll
            for (int m = 0; m < 4; ++m) { bf16_t* rowp = ob + ai * 8192 + m * 1024;
                const float rstd = __builtin_amdgcn_rsqf(rs[ai][m] * (1.f / DM) + EPS);
                float h[8];
#pragma unroll
                for (int n = 0; n < 2; ++n)
#pragma unroll
                    for (int e = 0; e < 4; ++e) { const float g = acc[ai][0][m][n][e] * rstd + sv[0][n][e], uu = acc[ai][1][m][n][e] * rstd + sv[1][n][e]; h[4 * n + e] = silu_f(g) * uu; }
                u32x4 w; w.x = cvt_pk_bf16(h[0], h[1]); w.y = cvt_pk_bf16(h[2], h[3]); w.z = cvt_pk_bf16(h[4], h[5]); w.w = cvt_pk_bf16(h[6], h[7]);
                *(u32x4*)rowp = w; }
    }
};
struct EpiResid {
    static constexpr bool PERM = true, AFTER_DRAIN = false;
    _Float16* X; const float* gate; bf16_t* XS; const float* gsn; float* rssn; float coef; int write_xs;
    __device__ __forceinline__ const float* src0(const Unit& u) const { return gate + (size_t)(u.pm >> 4) * NMOD + u.pn * BM; }
    __device__ __forceinline__ const float* src1(const Unit& u) const { return gsn + (u.pm >> 4) * DM + u.pn * BM; }
    __device__ __forceinline__ void operator()(const f32x4 (&acc)[2][2][4][2], const Unit& u, int wr, int wc, int fr, int fq, const PG8_LAS float* ep) const {
        typedef _Float16 f16x8 __attribute__((ext_vector_type(8)));
        const int col0 = u.pn * BM + wc * 32 + 8 * fq;
        f32x4 gv[2][2];
#pragma unroll
        for (int bj = 0; bj < 2; ++bj)
#pragma unroll
            for (int n = 0; n < 2; ++n) gv[bj][n] = *(const PG8_LAS f32x4*)(ep + wc * 32 + 8 * fq + bj * HALF + 4 * n);
        const PG8_LAS float* gsp = ep + 256 + wc * 32 + 8 * fq;
        bf16_t* xsb = XS + (size_t)(u.pm * (DM / BK) + 4 * u.pn + (wc >> 1)) * (BM * BK) + ((wr * 4) * 2 + (wc & 1)) * 512 + fr * 32 + 8 * fq;
        _Float16* xb = X + (size_t)u.pm * (BM * DM) + (size_t)(((u.pn * 8 + wc) * 16 + wr * 4) * 512) + fr * 32 + 8 * fq;
#pragma unroll
        for (int ai = 0; ai < 2; ++ai) {
            f16x8 xin[4][2];
#pragma unroll
            for (int m = 0; m < 4; ++m)
#pragma unroll
                for (int bj = 0; bj < 2; ++bj) xin[m][bj] = *(const f16x8*)(xb + bj * 32768 + ai * 4096 + m * 512);
            asm volatile("" ::: "memory");
            if (ai == 0) {
#pragma unroll
                for (int bj = 0; bj < 2; ++bj)
#pragma unroll
                    for (int n = 0; n < 2; ++n) gv[bj][n] = gv[bj][n] * coef; }
            float ssm = 0.f;
#pragma unroll
            for (int m = 0; m < 4; ++m) { const int row = u.pm * BM + ai * HALF + wr * 64 + m * 16 + fr; const size_t off = (size_t)row * DM + col0;
                float ss = 0.f;
#pragma unroll
                for (int bj = 0; bj < 2; ++bj) {
                    const f16x8 xi = xin[m][bj];
                    const f32x4 x0 = __builtin_convertvector(__builtin_shufflevector(xi, xi, 0, 1, 2, 3), f32x4), x1 = __builtin_convertvector(__builtin_shufflevector(xi, xi, 4, 5, 6, 7), f32x4);
                    const f32x4 o0 = x0 + acc[ai][bj][m][0] * gv[bj][0], o1 = x1 + acc[ai][bj][m][1] * gv[bj][1];
                    const f16x4 h0 = __builtin_convertvector(o0, f16x4), h1 = __builtin_convertvector(o1, f16x4);
                    *(f16x8*)(xb + bj * 32768 + ai * 4096 + m * 512) = __builtin_shufflevector(h0, h1, 0, 1, 2, 3, 4, 5, 6, 7);
                    ss += ((o0[0] * o0[0] + o0[1] * o0[1]) + (o0[2] * o0[2] + o0[3] * o0[3])) + ((o1[0] * o1[0] + o1[1] * o1[1]) + (o1[2] * o1[2] + o1[3] * o1[3]));
                    const f32x4 s0 = o0 * *(const PG8_LAS f32x4*)(gsp + bj * HALF), s1 = o1 * *(const PG8_LAS f32x4*)(gsp + bj * HALF + 4);
                    u32x4 w; w.x = cvt_pk_bf16(s0[0], s0[1]); w.y = cvt_pk_bf16(s0[2], s0[3]); w.z = cvt_pk_bf16(s1[0], s1[1]); w.w = cvt_pk_bf16(s1[2], s1[3]);
                    if (write_xs) *(u32x4*)(xsb + (size_t)(2 * bj) * BM * BK + ai * 8192 + m * 1024) = w; }
                ss += shx<16>(ss); ss += shx<32>(ss);
                if (fq == m) ssm = ss; }
            (void)__hip_atomic_fetch_add(rssn + (u.pm * BM + ai * HALF + wr * 64 + fq * 16 + fr), ssm, __ATOMIC_RELAXED, __HIP_MEMORY_SCOPE_AGENT);
            asm volatile("" ::: "memory");
        }
    }
};

template <class Epi, class Sched, bool ALIGN_EPI = false, bool SP2 = false>
__device__ __forceinline__ void gemm_phase(PG8_LAS unsigned char* lds, const Gemm g, const Sched& S, const Epi& E, const int WV) {
    GET_TID(tid);
    const int wid = WV, lane = tid & 63, wr = wid >> 2, wc = wid & 3, fr = lane & 15, fq = lane >> 4;
    const int K = g.K, nt = K / BK;
    unsigned voffA[2], voffB[2];
#pragma unroll
    for (int i = 0; i < 2; ++i) { int R, C; stage_rc(tid * 16 + i * 8192, R, C); const int Rb = Epi::PERM ? ((R & ~31) + perm32(R & 31)) : R;
        voffA[i] = g.atiled ? (unsigned)(((R >> 4) * 2 + (C >> 5)) * 1024 + (R & 15) * 64 + (C & 31) * 2) : (unsigned)(R * K + C) * 2u;
        voffB[i] = (unsigned)(((R >> 4) * 2 + (C >> 5)) * 1024 + (R & 15) * 64 + (C & 31) * 2); (void)Rb; }
    static_assert(Epi::PERM, "the stored weight layout carries the perm32 row order");
    const size_t kB = (size_t)BM * BK * 2, hB = (size_t)HALF * BK * 2, tB = (size_t)nt * BM * BK * 2;
    const size_t kA = g.atiled ? (size_t)BM * BK * 2 : (size_t)(BK * 2), hA = g.atiled ? (size_t)HALF * BK * 2 : (size_t)HALF * K * 2, tA = g.atiled ? (size_t)nt * BM * BK * 2 : (size_t)BM * K * 2;


    const unsigned ldsw = (unsigned)wid * 1024u;
    const int aoff = lds_byte(wr * 64 + fr, fq * 8), boff = lds_byte(wc * 32 + fr, fq * 8);
#define PG8_SA(b, h) (((b) * 2 + (h)) * HTB)
#define PG8_SB(b, h) ((4 + (b) * 2 + (h)) * HTB)
#define PG8_STAGE(bufoff, gbase, voff) do { _Pragma("unroll") for (int _i = 0; _i < 2; ++_i) \
        __builtin_amdgcn_global_load_lds((const unsigned*)((const char*)(gbase) + (voff)[_i]), (PG8_LAS unsigned*)(lds + (bufoff) + ldsw + _i * 8192), 16, 0, 0); } while (0)
#define PG8_LDA(dst, b, h) do { _Pragma("unroll") for (int m = 0; m < 4; ++m) _Pragma("unroll") for (int k = 0; k < 2; ++k) dst[m][k] = *(const PG8_LAS bf16x8*)(lds + PG8_SA(b, h) + aoff + m * 2048 + k * 1024); } while (0)
#define PG8_LDB(dst, b, h) do { _Pragma("unroll") for (int n = 0; n < 2; ++n) _Pragma("unroll") for (int k = 0; k < 2; ++k) dst[n][k] = *(const PG8_LAS bf16x8*)(lds + PG8_SB(b, h) + boff + n * 2048 + k * 1024); } while (0)
#define PG8_MMA(ai, bj, At, Bt) do { __builtin_amdgcn_s_setprio(1); _Pragma("unroll") for (int m = 0; m < 4; ++m) _Pragma("unroll") for (int n = 0; n < 2; ++n) _Pragma("unroll") for (int k = 0; k < 2; ++k) \
        acc[ai][bj][m][n] = __builtin_amdgcn_mfma_f32_16x16x32_bf16(Bt[n][k], At[m][k], acc[ai][bj][m][n], 0, 0, 0); __builtin_amdgcn_s_setprio(0); } while (0)
#define PG8_WAIT_V(n) asm volatile("s_waitcnt vmcnt(" #n ")" ::: "memory")
#define PG8_WAIT_L(n) asm volatile("s_waitcnt lgkmcnt(" #n ")" ::: "memory")
#define PG8_BAR __builtin_amdgcn_s_barrier()
#define PG8_SCHED __builtin_amdgcn_sched_barrier(0)
    Unit cur, nxt; int ui = 0;
    if (!S.next(0, cur)) return;
    f32x4 acc[2][2][4][2];
#pragma unroll
    for (int a = 0; a < 2; ++a)
#pragma unroll
        for (int b = 0; b < 2; ++b)
#pragma unroll
            for (int m = 0; m < 4; ++m)
#pragma unroll
                for (int n = 0; n < 2; ++n) acc[a][b][m][n] = (f32x4){0.f, 0.f, 0.f, 0.f};
    bf16x8 At[4][2], B0[2][2], B1[2][2];
    const char* cA = (const char*)g.A + (size_t)cur.pm * tA; const char* cB = (const char*)g.Bt + (size_t)cur.pn * tB;
    S.a_ready(cur);
    if constexpr (SP2) {
        PG8_STAGE(PG8_SB(0, 0), cB, voffB); PG8_STAGE(PG8_SB(0, 1), cB + hB, voffB); PG8_STAGE(PG8_SA(0, 0), cA, voffA); PG8_STAGE(PG8_SA(0, 1), cA + hA, voffA);
        if (wr == 1) PG8_BAR;
        PG8_WAIT_V(2); PG8_BAR;
        PG8_STAGE(PG8_SB(1, 0), cB + kB, voffB); PG8_STAGE(PG8_SA(1, 0), cA + kA, voffA); PG8_STAGE(PG8_SB(1, 1), cB + hB + kB, voffB);
        PG8_WAIT_V(6); PG8_BAR;
    } else {
        PG8_STAGE(PG8_SB(0, 0), cB, voffB); PG8_STAGE(PG8_SA(0, 0), cA, voffA); PG8_STAGE(PG8_SB(0, 1), cB + hB, voffB); PG8_STAGE(PG8_SA(0, 1), cA + hA, voffA);
        if (wr == 1) PG8_BAR;
        PG8_WAIT_V(4); PG8_BAR;
        PG8_STAGE(PG8_SB(1, 0), cB + kB, voffB); PG8_STAGE(PG8_SA(1, 0), cA + kA, voffA); PG8_STAGE(PG8_SB(1, 1), cB + hB + kB, voffB);
        PG8_WAIT_V(6); PG8_BAR;
    }
    for (;;) {
        const bool has_next = S.next(ui + 1, nxt);
        const char* nA = has_next ? (const char*)g.A + (size_t)nxt.pm * tA : cA; const char* nB = has_next ? (const char*)g.Bt + (size_t)nxt.pn * tB : cB;
        for (int t = 0; t < nt; t += 2) {
            const bool last = (t == nt - 2);
            const char* a1 = cA + (size_t)(t + 1) * kA;
            const char* a2 = last ? nA : cA + (size_t)(t + 2) * kA; const char* b2 = last ? nB : cB + (size_t)(t + 2) * kB;
            const char* a3 = a2 + kA; const char* b3 = b2 + kB;
            if (last && has_next) S.a_ready(nxt);
            if constexpr (SP2) {
            { const float* es_ = (wid < 4 ? E.src0(cur) + wid * 64 : E.src1(cur) + (wid - 4) * 64) + lane; const unsigned eo_ = EPI_OFF + (last ? 0u : 2048u) + wid * 256;
            PG8_LDB(B0, 0, 0); PG8_LDB(B1, 0, 1); PG8_SCHED; PG8_LDA(At, 0, 0); PG8_STAGE(PG8_SA(1, 1), a1 + hA, voffA);
            __builtin_amdgcn_global_load_lds((const unsigned*)es_, (PG8_LAS unsigned*)(lds + eo_), 4, 0, 0); }
            PG8_WAIT_V(9); PG8_WAIT_L(0); PG8_BAR; PG8_MMA(0, 0, At, B0); PG8_MMA(0, 1, At, B1); PG8_BAR; PG8_SCHED;
            PG8_LDA(At, 0, 1); PG8_STAGE(PG8_SB(0, 0), b2, voffB); PG8_STAGE(PG8_SB(0, 1), b2 + hB, voffB); PG8_STAGE(PG8_SA(0, 0), a2, voffA);
            PG8_WAIT_V(9); PG8_WAIT_L(0); PG8_BAR; PG8_MMA(1, 0, At, B0); PG8_MMA(1, 1, At, B1); PG8_BAR; PG8_SCHED;
            PG8_LDB(B0, 1, 0); PG8_LDB(B1, 1, 1); PG8_SCHED; PG8_LDA(At, 1, 0); PG8_STAGE(PG8_SA(0, 1), a2 + hA, voffA);
            PG8_WAIT_V(9); PG8_WAIT_L(0); PG8_BAR; PG8_MMA(0, 0, At, B0); PG8_MMA(0, 1, At, B1); PG8_BAR; PG8_SCHED;
            PG8_LDA(At, 1, 1); PG8_STAGE(PG8_SB(1, 0), b3, voffB); PG8_STAGE(PG8_SB(1, 1), b3 + hB, voffB); PG8_STAGE(PG8_SA(1, 0), a3, voffA);
            PG8_WAIT_V(8); PG8_WAIT_L(0); PG8_BAR; PG8_MMA(1, 0, At, B0); PG8_MMA(1, 1, At, B1); PG8_BAR; PG8_SCHED;
            } else {
            PG8_LDB(B0, 0, 0); PG8_SCHED; PG8_LDA(At, 0, 0); PG8_STAGE(PG8_SA(1, 1), a1 + hA, voffA);
            PG8_WAIT_L(8); PG8_BAR; PG8_WAIT_L(0); PG8_MMA(0, 0, At, B0); PG8_BAR; PG8_SCHED;
            PG8_LDB(B1, 0, 1); PG8_STAGE(PG8_SB(0, 0), b2, voffB);
            PG8_BAR; PG8_WAIT_L(0); PG8_MMA(0, 1, At, B1); PG8_BAR;
            PG8_LDA(At, 0, 1); PG8_STAGE(PG8_SA(0, 0), a2, voffA);
            PG8_BAR; PG8_WAIT_L(0); PG8_MMA(1, 0, At, B0); PG8_BAR; PG8_SCHED;
            PG8_STAGE(PG8_SB(0, 1), b2 + hB, voffB);
            PG8_WAIT_V(6); PG8_BAR; PG8_MMA(1, 1, At, B1); PG8_BAR;
            PG8_LDB(B0, 1, 0); PG8_SCHED; PG8_LDA(At, 1, 0); PG8_STAGE(PG8_SA(0, 1), a2 + hA, voffA);
            PG8_WAIT_L(8); PG8_BAR; PG8_WAIT_L(0); PG8_MMA(0, 0, At, B0); PG8_BAR; PG8_SCHED;
            PG8_LDB(B1, 1, 1); PG8_STAGE(PG8_SB(1, 0), b3, voffB);
            PG8_BAR; PG8_WAIT_L(0); PG8_MMA(0, 1, At, B1); PG8_BAR;
            PG8_LDA(At, 1, 1); PG8_STAGE(PG8_SA(1, 0), a3, voffA);
            PG8_BAR; PG8_WAIT_L(0); PG8_MMA(1, 0, At, B0); PG8_BAR; PG8_SCHED;
            PG8_STAGE(PG8_SB(1, 1), b3 + hB, voffB);
            PG8_WAIT_V(6); PG8_BAR; PG8_MMA(1, 1, At, B1); PG8_BAR;
            }
        }
        if constexpr (ALIGN_EPI) { if (wr == 0) PG8_BAR; }
        if constexpr (!Epi::AFTER_DRAIN) { E(acc, cur, wr, wc, fr, fq, (const PG8_LAS float*)(lds + EPI_OFF)); S.done(cur); }
        if (!has_next) break;
#pragma unroll
        for (int a = 0; a < 2; ++a)
#pragma unroll
            for (int b = 0; b < 2; ++b)
#pragma unroll
                for (int m = 0; m < 4; ++m)
#pragma unroll
                    for (int n = 0; n < 2; ++n) acc[a][b][m][n] = (f32x4){0.f, 0.f, 0.f, 0.f};
        cur = nxt; cA = nA; cB = nB; ++ui;
        if constexpr (ALIGN_EPI) { if (wr == 1) PG8_BAR; }
    }
    PG8_WAIT_V(0);
    if constexpr (!ALIGN_EPI) { if (wr == 0) PG8_BAR; }
    PG8_BAR;
#undef PG8_SA
#undef PG8_SB
#undef PG8_STAGE
#undef PG8_LDA
#undef PG8_LDB
#undef PG8_MMA
#undef PG8_WAIT_V
#undef PG8_WAIT_L
#undef PG8_BAR
#undef PG8_SCHED
}
}

constexpr size_t MiB = 1u << 20;
constexpr size_t WS_RSS = 65536;
constexpr size_t WS_ZERO_BYTES = 1 * MiB;
constexpr size_t WS_MOD = 1 * MiB;
constexpr size_t WS_GS = 1 * MiB + 640 * 1024;
constexpr size_t WS_SW = 5 * MiB;
constexpr size_t WS_GWT = 2 * MiB;
constexpr size_t WS_SPW = 3 * MiB;
constexpr size_t WS_AGG = 4 * MiB;
constexpr size_t WS_W = 8 * MiB;
constexpr size_t WL_GU1 = 0, WL_DOWN1 = 11 * MiB, WL_WIN = WL_DOWN1 + 5 * MiB + MiB / 2, WL_WOUT = WL_WIN + 4 * MiB, WL_GU2 = WL_WOUT + 2 * MiB, WL_DOWN2 = WL_GU2 + 11 * MiB, WL_SIZE = 39 * MiB;
constexpr size_t WS_H = 88 * MiB;
constexpr size_t WS_ACT = 152 * MiB;
constexpr size_t WS_Y = 328 * MiB;
constexpr size_t WS_X16 = 392 * MiB;
constexpr size_t WS_END = 456 * MiB;
static_assert(WL_DOWN2 + 5 * MiB + MiB / 2 == WL_SIZE && WS_W + 2 * WL_SIZE <= WS_H, "ws map");

constexpr int LDS_MISC_OFF = 143360;
constexpr int LDS_BYTES = 147456;
constexpr int NWAVES = 8;

struct Args { const float* in[26]; float* out; unsigned char* ws; int lo, hi; };
#define AIN(i) ((const float*)(((const GAS float* const volatile __attribute__((address_space(4)))*)__builtin_amdgcn_kernarg_segment_ptr())[i]))
enum { I_X = 0, I_C, I_WADA, I_BADA, I_F1N, I_F1GU, I_F1D, I_MIXN, I_WIN, I_CONVW, I_CONVB, I_GAW, I_GAB, I_GXW, I_GXB, I_LAM, I_VN, I_SPW, I_SPB, I_LON, I_GON, I_WOUT, I_F2N, I_F2GU, I_F2D, I_FIN };

__device__ __forceinline__ void transpose_item(const float* W, int K, int N, bf16* WT, int mode, LAS float* scr, int item, int lane) {
    const int nblk = N / 32, kb = item / nblk, nb = item % nblk, k0 = 64 * kb, n0 = 32 * nb;
    int drow0 = n0;
    if (mode == 1) { const int j = n0 < DFF ? n0 : n0 - DFF; drow0 = 256 * (j >> 7) + (j & 127) + (n0 < DFF ? 0 : 128); }
#pragma unroll 8
    for (int i = 0; i < 32; ++i) { const int kk = 2 * i + (lane >> 5); scr[kk * 33 + (lane & 31)] = W[(size_t)(k0 + kk) * N + n0 + (lane & 31)]; }
    LDS_WAIT();
    const int srow = lane >> 2, cc = lane & 3;
#pragma unroll
    for (int j = 0; j < 4; ++j) { const int rg = j >> 1, kh = j & 1, n = pg8::perm32(16 * rg + srow), c = kh * 4 + cc; const LAS float* s = scr + (8 * c) * 33 + n;
        u32x4 o; o.x = pk2(s[0 * 33], s[1 * 33]); o.y = pk2(s[2 * 33], s[3 * 33]); o.z = pk2(s[4 * 33], s[5 * 33]); o.w = pk2(s[6 * 33], s[7 * 33]);
        *(u32x4*)(WT + pg8::wtile_off(drow0 + n, k0 + 8 * c, K / 64)) = o; }
    LDS_WAIT();
}

__device__ __forceinline__ void p0_phase(const Args& a, LAS unsigned char* lds, int G, const int WV) {
    GET_TID(tid);
    const int lane = tid & 63, wave = WV;
    GAS unsigned char* wsg_ = (GAS unsigned char*)a.ws; asm volatile("" : "+s"(wsg_)); unsigned char* ws = (unsigned char*)wsg_;
    {
        LAS float* scL = (LAS float*)lds;
        LAS float* red = (LAS float*)(lds + 32768);
        for (int i = tid; i < NB * DM; i += 512) { const int b = i >> 10, k = i & 1023; scL[k * 8 + b] = silu_f(AIN(I_C)[i]); }
        __syncthreads();
        float* mod = (float*)(ws + WS_MOD);
        for (int item = blockIdx.x; item < DEPTH * (NMOD / 64); item += G) {
            const int l = item / (NMOD / 64), grp = item % (NMOD / 64), n = 64 * grp + lane;
            const float* W = AIN(I_WADA) + (size_t)l * DM * NMOD + n;
            float acc[8];
#pragma unroll
            for (int b = 0; b < 8; ++b) acc[b] = 0.f;
#pragma unroll 16
            for (int kk = 0; kk < 128; ++kk) { const int k = 128 * wave + kk; const float w = W[(size_t)k * NMOD];
                const f32x4 s0 = *(const LAS f32x4*)(scL + k * 8), s1 = *(const LAS f32x4*)(scL + k * 8 + 4);
                acc[0] += w * s0[0]; acc[1] += w * s0[1]; acc[2] += w * s0[2]; acc[3] += w * s0[3];
                acc[4] += w * s1[0]; acc[5] += w * s1[1]; acc[6] += w * s1[2]; acc[7] += w * s1[3]; }
#pragma unroll
            for (int b = 0; b < 8; ++b) red[(wave * 8 + b) * 64 + lane] = acc[b];
            __syncthreads();
            { const int b = wave; float s = 0.f;
#pragma unroll
              for (int w = 0; w < 8; ++w) s += red[(w * 8 + b) * 64 + lane];
              mod[(size_t)(l * 8 + b) * NMOD + n] = s + AIN(I_BADA)[(size_t)l * NMOD + n]; }
            __syncthreads();
        }
    }
    {
        const int gt = blockIdx.x * 512 + tid, NT = G * 512;
        bf16* gwt = (bf16*)(ws + WS_GWT);
        for (int i = gt; i < DEPTH * 2 * 8 * 64 * 64; i += NT) {
            const int d = i & 63, e = (i >> 6) & 63, h = (i >> 12) & 7, g = (i >> 15) & 1, l = i >> 16;
            const float* src = g ? AIN(I_GXW) : AIN(I_GAW);
            gwt[i] = (bf16)f2bf(src[(((size_t)l * 8 + h) * 64 + d) * 64 + e]);
        }
        bf16* spw = (bf16*)(ws + WS_SPW);
        for (int i = gt; i < DEPTH * 8 * 128 * 128; i += NT) { const int s = i & 127, t = (i >> 7) & 127; spw[i] = (s <= t) ? (bf16)f2bf(AIN(I_SPW)[i]) : (bf16)0; }
    }
    {
        LAS float* scr = (LAS float*)(lds + wave * 16384);
        const int gw = blockIdx.x * NWAVES + wave, NGW = G * NWAVES;
        constexpr int I_GU = (DM / 64) * (NGU / 32), I_DN = (DFF / 64) * (DM / 32), I_IN = (DM / 64) * (NIN / 32), I_OUT = (DM / 64) * (DM / 32);
        constexpr int PER_L = 2 * I_GU + 2 * I_DN + I_IN + I_OUT;
        for (int it = gw; it < DEPTH * PER_L; it += NGW) {
            const int l = it / PER_L; int r = it % PER_L;
            unsigned char* wl = ws + WS_W + (size_t)l * WL_SIZE;
            if (r < I_GU) { transpose_item(AIN(I_F1GU) + (size_t)l * DM * NGU, DM, NGU, (bf16*)(wl + WL_GU1), 1, scr, r, lane); continue; } r -= I_GU;
            if (r < I_GU) { transpose_item(AIN(I_F2GU) + (size_t)l * DM * NGU, DM, NGU, (bf16*)(wl + WL_GU2), 1, scr, r, lane); continue; } r -= I_GU;
            if (r < I_DN) { transpose_item(AIN(I_F1D) + (size_t)l * DFF * DM, DFF, DM, (bf16*)(wl + WL_DOWN1), 0, scr, r, lane); continue; } r -= I_DN;
            if (r < I_DN) { transpose_item(AIN(I_F2D) + (size_t)l * DFF * DM, DFF, DM, (bf16*)(wl + WL_DOWN2), 0, scr, r, lane); continue; } r -= I_DN;
            if (r < I_IN) { transpose_item(AIN(I_WIN) + (size_t)l * DM * NIN, DM, NIN, (bf16*)(wl + WL_WIN), 0, scr, r, lane); continue; } r -= I_IN;
            transpose_item(AIN(I_WOUT) + (size_t)l * DM * DM, DM, DM, (bf16*)(wl + WL_WOUT), 0, scr, r, lane);
        }
    }
}

__device__ __forceinline__ void norm0_phase(const float* Xin, _Float16* Xcopy, const float* gain, const float* scale, bf16* XS, float* rss, int G, const int WV) {
    GET_TID(tid_);
    const int lane = tid_ & 63, wave = tid_ >> 6, gw = blockIdx.x * NWAVES + wave, NGW = G * NWAVES, fr = lane & 15, fq = lane >> 4;
    for (int rgi = gw; rgi < M / 16; rgi += NGW) {
        const int m = rgi * 16 + fr, b = m >> 12;
        const float* xr = Xin + (size_t)m * DM + 8 * fq; const float* gp = gain + 8 * fq; const float* sc = scale + (size_t)b * NMOD + 8 * fq;
        _Float16* xc = Xcopy + (size_t)(m >> 8) * (256 * DM) + (size_t)(((m & 255) >> 4) * 512) + fr * 32 + 8 * fq;
        bf16* xst = XS + (size_t)(m >> 8) * (16 * 16384) + ((m & 255) >> 7) * 8192 + (((m & 127) >> 4) * 2) * 512 + fr * 32 + 8 * fq;
        float s = 0.f;
#pragma unroll 4
        for (int cg = 0; cg < 32; ++cg) {
            const f32x4 v0 = *(const f32x4*)(xr + cg * 32), v1 = *(const f32x4*)(xr + cg * 32 + 4);
            const f32x4 g0 = *(const f32x4*)(gp + cg * 32), g1 = *(const f32x4*)(gp + cg * 32 + 4), c0 = *(const f32x4*)(sc + cg * 32), c1 = *(const f32x4*)(sc + cg * 32 + 4);
            s += ((v0.x * v0.x + v0.y * v0.y) + (v0.z * v0.z + v0.w * v0.w)) + ((v1.x * v1.x + v1.y * v1.y) + (v1.z * v1.z + v1.w * v1.w));
            typedef _Float16 f16x8 __attribute__((ext_vector_type(8)));
            const f16x4 h0 = __builtin_convertvector(v0, f16x4), h1 = __builtin_convertvector(v1, f16x4);
            *(f16x8*)(xc + (size_t)cg * 16 * 512) = __builtin_shufflevector(h0, h1, 0, 1, 2, 3, 4, 5, 6, 7);
            const f32x4 o0 = v0 * g0 * (c0 + 1.0f), o1 = v1 * g1 * (c1 + 1.0f);
            u32x4 w; w.x = pk2(o0.x, o0.y); w.y = pk2(o0.z, o0.w); w.z = pk2(o1.x, o1.y); w.w = pk2(o1.z, o1.w);
            *(u32x4*)(xst + (size_t)(cg >> 1) * 16384 + (cg & 1) * 512) = w;
        }
        s += shx<16>(s); s += shx<32>(s);
        if (fq == 0) rss[m] = s;
    }
}
__device__ __forceinline__ void prep_phase(const Args& a, LAS unsigned char* lds, int G, const int WV) {
    GET_TID(tid);
    const int lane = tid & 63, wave = WV;
    GAS unsigned char* wsg_ = (GAS unsigned char*)a.ws; asm volatile("" : "+s"(wsg_)); unsigned char* ws = (unsigned char*)wsg_;
    const float* mod = (const float*)(ws + WS_MOD);
    float* GS = (float*)(ws + WS_GS); float* SW = (float*)(ws + WS_SW);
    const int gt = blockIdx.x * 512 + tid, NT = G * 512;
    for (int i = gt; i < DEPTH * 3 * NB * DM; i += NT) { const int col = i & 1023, b = (i >> 10) & 7, ls = i >> 13, l = ls / 3, sub = ls % 3;
        const float gain = (sub == 0 ? AIN(I_F1N) : sub == 1 ? AIN(I_MIXN) : AIN(I_F2N))[l * DM + col];
        GS[i] = gain * (1.0f + mod[((size_t)(l * 8 + b) * 9 + 3 * sub + 1) * DM + col]); }
    LAS float* shL = (LAS float*)lds;
    const int gw = blockIdx.x * NWAVES + wave, NGW = G * NWAVES;
    for (int ls = 0; ls < DEPTH * 3; ++ls) {
        const int l = ls / 3, sub = ls % 3;
        __syncthreads();
        for (int i = tid; i < NB * DM; i += 512) { const int b = i >> 10, k = i & 1023; shL[i] = mod[((size_t)(l * 8 + b) * 9 + 3 * sub) * DM + k]; }
        __syncthreads();
        const bf16* Wt = (const bf16*)(ws + WS_W + (size_t)l * WL_SIZE + (sub == 0 ? WL_GU1 : sub == 1 ? WL_WIN : WL_GU2));
        const int nrows = (sub == 1) ? NIN : NGU;
        float* swb = SW + (size_t)ls * NB * 5632;
        for (int base = gw; base < nrows; base += 3 * NGW) {
        u32x4 wq[3][2];
#pragma unroll
        for (int i = 0; i < 3; ++i) { const int row = base + i * NGW; const int rr = row < nrows ? row : 0;
            wq[i][0] = *(const u32x4*)(Wt + pg8::wtile_off(rr, lane * 16, DM / 64)); wq[i][1] = *(const u32x4*)(Wt + pg8::wtile_off(rr, lane * 16 + 8, DM / 64)); }
#pragma unroll
        for (int i = 0; i < 3; ++i) { const int row = base + i * NGW;
            if (row < nrows) {
                const u32x4 w0 = wq[i][0], w1 = wq[i][1];
                float wf[16];
#pragma unroll
                for (int j = 0; j < 4; ++j) { wf[2 * j] = bf2f(w0[j] & 0xffffu); wf[2 * j + 1] = __uint_as_float(w0[j] & 0xffff0000u); wf[8 + 2 * j] = bf2f(w1[j] & 0xffffu); wf[8 + 2 * j + 1] = __uint_as_float(w1[j] & 0xffff0000u); }
                float a8[8];
#pragma unroll
                for (int b = 0; b < 8; ++b) { const LAS f32x4* sp = (const LAS f32x4*)(shL + b * DM + lane * 16); float sacc = 0.f;
#pragma unroll
                    for (int q = 0; q < 4; ++q) { const f32x4 sv = sp[q]; sacc += wf[4 * q] * sv[0] + wf[4 * q + 1] * sv[1] + wf[4 * q + 2] * sv[2] + wf[4 * q + 3] * sv[3]; }
                    a8[b] = sacc; }
                const bool h5 = (lane & 32) != 0, h4 = (lane & 16) != 0, h3 = (lane & 8) != 0;
                float k4[4], k2[2], k1;
#pragma unroll
                for (int j = 0; j < 4; ++j) k4[j] = (h5 ? a8[4 + j] : a8[j]) + shx<32>(h5 ? a8[j] : a8[4 + j]);
#pragma unroll
                for (int j = 0; j < 2; ++j) k2[j] = (h4 ? k4[2 + j] : k4[j]) + shx<16>(h4 ? k4[j] : k4[2 + j]);
                k1 = (h3 ? k2[1] : k2[0]) + shx<8>(h3 ? k2[0] : k2[1]);
                k1 += shx<4>(k1); k1 += shx<2>(k1); k1 += shx<1>(k1);
                const int b = (h5 ? 4 : 0) + (h4 ? 2 : 0) + (h3 ? 1 : 0);
                if ((lane & 7) == 0) swb[b * 5632 + row] = k1;
            } }
        }
    }
}
__device__ __forceinline__ void final_phase(const _Float16* X, float* out, const float* gain, const float* rss, int G, const int WV) {
    GET_TID(tid_);
    const int lane = tid_ & 63, wave = tid_ >> 6, gw = blockIdx.x * NWAVES + wave, NGW = G * NWAVES;
    for (int m = gw; m < M; m += NGW) {
        const _Float16* xr = X + (size_t)(m >> 8) * (256 * DM) + (size_t)(((lane >> 3) * 16 + ((m & 255) >> 4)) * 512) + (m & 15) * 32 + 4 * (lane & 7);
        f32x4* orow = (f32x4*)(out + (size_t)m * DM) + lane;
        const float rstd = __builtin_amdgcn_rsqf(rss[m] * (1.f / DM) + EPS);
        const f32x4* gp = (const f32x4*)gain + lane;
#pragma unroll
        for (int j = 0; j < 4; ++j) orow[64 * j] = __builtin_convertvector(*(const f16x4*)(xr + (size_t)(8 * j) * 16 * 512), f32x4) * rstd * gp[64 * j];
    }
}

#define MFMA32(a, b, c) __builtin_amdgcn_mfma_f32_32x32x16_bf16((a), (b), (c), 0, 0, 0)
__device__ __forceinline__ int crow(int reg, int h) { return (reg & 3) + 8 * (reg >> 2) + 4 * h; }

constexpr int M1_WAVE_LDS = 17408, M1_PART_OFF = 8 * M1_WAVE_LDS;

typedef _Float16 f16x2 __attribute__((ext_vector_type(2)));
template <bool FINAL>
__device__ __forceinline__ void lru_pass(const Args& a, LAS unsigned char* lds, int l, int item, int tid, int h) {
    GAS unsigned char* wsg_ = (GAS unsigned char*)a.ws; asm volatile("" : "+s"(wsg_)); unsigned char* ws = (unsigned char*)wsg_;
    const bf16* PROJ = (const bf16*)(ws + WS_ACT);
    bf16* Y = (bf16*)(ws + WS_Y);
    float* AGG = (float*)(ws + WS_AGG);
    unsigned* LI = (unsigned*)(ws + WS_H);
    const bf16* GWT = (const bf16*)(ws + WS_GWT);
    LAS unsigned char* wl = lds + h * M1_WAVE_LDS;
    LAS unsigned short* xcL = (LAS unsigned short*)wl;
    LAS float* xcF = (LAS float*)(wl + 4608);
    LAS float* part = (LAS float*)(lds + M1_PART_OFF);
    const int c = item & 31; const size_t r0 = (size_t)item * 128;
    unsigned lane = tid & 63; asm volatile("" : "+v"(lane));
    const unsigned r = lane & 31, hh = lane >> 5;
    const int chb = 64 * h;
    const bf16* Pu = PROJ + (size_t)(item >> 1) * (32 * 16384) + (size_t)h * 16384 + (item & 1) * 8192;
    const unsigned lo_x = (lane >> 5) * 512 + (lane & 31);
    float w0 = 0.f, w1 = 0.f, w2 = 0.f, w3 = 0.f, cb = 0.f, xm3 = 0.f, xm2 = 0.f, xm1 = 0.f;
    float ba_[2], bx_[2], c8[2], Arun[2], Hrun[2], lon[2];
#pragma unroll
    for (int nb = 0; nb < 2; ++nb) { ba_[nb] = 0.f; bx_[nb] = 0.f; c8[nb] = 0.f; Arun[nb] = 1.f; Hrun[nb] = 0.f; lon[nb] = 0.f; }
    if constexpr (!FINAL) {
        w0 = (AIN(I_CONVW) + (l * 4 + 0) * LW + chb)[lane]; w1 = (AIN(I_CONVW) + (l * 4 + 1) * LW + chb)[lane]; w2 = (AIN(I_CONVW) + (l * 4 + 2) * LW + chb)[lane]; w3 = (AIN(I_CONVW) + (l * 4 + 3) * LW + chb)[lane];
        cb = (AIN(I_CONVB) + l * LW + chb)[lane];
        if (c > 0) { const bf16* Pp = PROJ + (size_t)((item - 1) >> 1) * (32 * 16384) + (size_t)h * 16384 + ((item - 1) & 1) * 8192 + (7 * 2) * 512;
            xm3 = bf2f((Pp + 13 * 32)[lo_x]); xm2 = bf2f((Pp + 14 * 32)[lo_x]); xm1 = bf2f((Pp + 15 * 32)[lo_x]); }
#pragma unroll
        for (int nb = 0; nb < 2; ++nb) { ba_[nb] = (AIN(I_GAB) + (l * 8 + h) * 64 + 32 * nb)[r]; bx_[nb] = (AIN(I_GXB) + (l * 8 + h) * 64 + 32 * nb)[r];
            const float lam = (AIN(I_LAM) + l * LW + chb + 32 * nb)[r]; c8[nb] = -8.0f * 1.4426950408889634f * log1pf(expf(-lam));
            ba_[nb] *= -1.4426950408889634f; bx_[nb] *= -1.4426950408889634f; }
    } else {
        const int b = item >> 5;
#pragma unroll
        for (int nb = 0; nb < 2; ++nb) { lon[nb] = (AIN(I_LON) + l * LW + chb + 32 * nb)[r];
            f32x2 ag[31]; const f32x2* agb = (const f32x2*)(AGG + ((size_t)(b * 32) * LW + chb + 32 * nb) * 2);
#pragma unroll
            for (int cc = 0; cc < 31; ++cc) ag[cc] = (agb + cc * LW)[r];
            float hc = 0.f;
#pragma unroll
            for (int cc = 0; cc < 31; ++cc) hc = (cc < c) ? ag[cc].x * hc + ag[cc].y : hc;
            Hrun[nb] = hc; }
    }
#pragma unroll 1
    for (int tb = 0; tb < 4; ++tb) {
        unsigned ln = lane; asm volatile("" : "+v"(ln));
        const unsigned r_ = ln & 31, hh_ = ln >> 5;
        const bf16* Pt = Pu + (size_t)(4 * tb) * 512;
        u32x4* liq = (u32x4*)LI + ((r0 + 32 * tb) >> 2) * LW + chb;
        const unsigned lo_l = hh_ * LW + r_;
        float y[2][16];
        if constexpr (!FINAL) {
            bf16x8 Bg[2][2][4];
            { const bf16* gb = GWT + ((size_t)(l * 2) * 8 + h) * 4096; const unsigned go = r_ * 64 + 8 * hh_;
#pragma unroll
              for (int g = 0; g < 2; ++g)
#pragma unroll
                for (int nb = 0; nb < 2; ++nb)
#pragma unroll
                    for (int kk = 0; kk < 4; ++kk) Bg[g][nb][kk] = *(const bf16x8*)(gb + g * 8 * 4096 + 32 * nb * 64 + 16 * kk + go); }
            unsigned short xraw[32];
#pragma unroll
            for (int t = 0; t < 32; ++t) xraw[t] = (Pt + ((t >> 4) * 2) * 512 + (t & 15) * 32)[(ln >> 5) * 512 + (ln & 31)];
#pragma unroll
            for (int t = 0; t < 32; ++t) {
                const float xv = bf2f(xraw[t]);
                float xc = cb + w0 * xm3; xc += w1 * xm2; xc += w2 * xm1; xc += w3 * xv;
                xm3 = xm2; xm2 = xm1; xm1 = xv;
                xcL[t * 72 + ln] = (unsigned short)f2bf_hw(xc); xcF[t * 64 + ln] = xc;
            }
            LDS_WAIT();
            bf16x8 Af[4];
            { const LAS unsigned short* xa = xcL + r_ * 72 + 8 * hh_;
#pragma unroll
              for (int kk = 0; kk < 4; ++kk) Af[kk] = *(const LAS bf16x8*)(xa + 16 * kk); }
            const LAS float* xcFb = xcF + hh_ * 256 + r_;
#pragma unroll
            for (int nb = 0; nb < 2; ++nb) {
                f32x16 accA, accX;
#pragma unroll
                for (int i = 0; i < 16; ++i) { accA[i] = 0.f; accX[i] = 0.f; }
#pragma unroll
                for (int kk = 0; kk < 4; ++kk) { accA = MFMA32(Af[kk], Bg[0][nb][kk], accA); accX = MFMA32(Af[kk], Bg[1][nb][kk], accX); }
#pragma unroll
                for (int g = 0; g < 4; ++g) {
                    float As = 1.f, Hs = 0.f; u32x4 pk4;
#pragma unroll
                    for (int q = 0; q < 4; ++q) { const int v = 4 * g + q, tc = 8 * g + q;
                        const float rr = __builtin_amdgcn_rcpf(1.0f + __builtin_amdgcn_exp2f(__builtin_fmaf(accA[v], -1.4426950408889634f, ba_[nb]))), ii = __builtin_amdgcn_rcpf(1.0f + __builtin_amdgcn_exp2f(__builtin_fmaf(accX[v], -1.4426950408889634f, bx_[nb])));
                        f16x2 pk; pk.x = (_Float16)(c8[nb] * rr);
                        const float la = (float)pk.x, av = __builtin_amdgcn_exp2f(la), mult = __builtin_amdgcn_sqrtf(__builtin_fmaf(-av, av, 1.0f));
                        const float xcv = xcFb[tc * 64 + 32 * nb];
                        pk.y = (_Float16)(mult * (ii * xcv)); const float iv = (float)pk.y;
                        pk4[q] = __builtin_bit_cast(unsigned, pk);
                        Hs = av * Hs + iv; As *= av; }
                    (liq + (2 * g) * LW + 32 * nb)[lo_l] = pk4;
                    const float pA = shx<32>(As), pH = shx<32>(Hs);
                    const float A1 = hh_ ? pA : As, H1 = hh_ ? pH : Hs, A2 = hh_ ? As : pA, H2 = hh_ ? Hs : pH;
                    const float Ac = A1 * A2, Hc = A2 * H1 + H2;
                    Hrun[nb] = Ac * Hrun[nb] + Hc; Arun[nb] *= Ac;
                }
            }
        } else {
            unsigned liraw[2][16]; unsigned short graw[2][16];
            const unsigned lo_g = hh_ * 128 + r_;
#pragma unroll
            for (int nb = 0; nb < 2; ++nb)
#pragma unroll
                for (int g = 0; g < 4; ++g) { const u32x4 t4 = (liq + (2 * g) * LW + 32 * nb)[lo_l]; liraw[nb][4 * g] = t4.x; liraw[nb][4 * g + 1] = t4.y; liraw[nb][4 * g + 2] = t4.z; liraw[nb][4 * g + 3] = t4.w;
#pragma unroll
                    for (int q = 0; q < 4; ++q) { const int v = 4 * g + q, tc = q + 8 * g; graw[nb][v] = (Pt + 8 * 16384 + ((g >> 1) * 2 + nb) * 512 + (8 * (g & 1) + q) * 32)[lo_g]; (void)tc; } }
#pragma unroll
            for (int nb = 0; nb < 2; ++nb)
#pragma unroll
                for (int g = 0; g < 4; ++g) {
                    float As = 1.f, Hs = 0.f, av[4], iv[4];
#pragma unroll
                    for (int q = 0; q < 4; ++q) { const f16x2 pk = __builtin_bit_cast(f16x2, liraw[nb][4 * g + q]); av[q] = __builtin_amdgcn_exp2f((float)pk.x); iv[q] = (float)pk.y; Hs = av[q] * Hs + iv[q]; As *= av[q]; }
                    const float pA = shx<32>(As), pH = shx<32>(Hs);
                    const float A1 = hh_ ? pA : As, H1 = hh_ ? pH : Hs, A2 = hh_ ? As : pA, H2 = hh_ ? Hs : pH;
                    float hcur = hh_ ? (A1 * Hrun[nb] + H1) : Hrun[nb];
#pragma unroll
                    for (int q = 0; q < 4; ++q) { hcur = av[q] * hcur + iv[q]; y[nb][4 * g + q] = hcur * gelu_tanh(bf2f(graw[nb][4 * g + q])); }
                    const float Ac = A1 * A2, Hc = A2 * H1 + H2;
                    Hrun[nb] = Ac * Hrun[nb] + Hc;
                }
            const int pb = tb & 1;
            LAS float* pw = part + pb * 256 + hh_ * 32 + h;
#pragma unroll
            for (int v = 0; v < 16; ++v) { const int tc = (v & 3) + 8 * (v >> 2);
                float ss = y[0][v] * y[0][v] + y[1][v] * y[1][v];
                ss += shx<1>(ss); ss += shx<2>(ss); ss += shx<4>(ss); ss += shx<8>(ss); ss += shx<16>(ss);
                if (r_ == 0) pw[tc * 8] = ss; }
            LDS_WAIT(); __syncthreads();
            bf16* yrow = Y + (size_t)(item >> 1) * (256 * DM) + (size_t)h * 16384 + (item & 1) * 8192 + (4 * tb) * 512;
            const LAS float* pr = part + pb * 256 + hh_ * 32;
            const unsigned lo_y = hh_ * 128 + r_;
#pragma unroll
            for (int v = 0; v < 16; ++v) { const int tc = (v & 3) + 8 * (v >> 2);
                const f32x4 p0 = *(const LAS f32x4*)(pr + tc * 8), p1 = *(const LAS f32x4*)(pr + tc * 8 + 4);
                const float tot = ((p0[0] + p0[1]) + (p0[2] + p0[3])) + ((p1[0] + p1[1]) + (p1[2] + p1[3]));
                const float rstd = __builtin_amdgcn_rsqf(tot * (1.f / LW) + EPS);
                bf16* yp = yrow + ((v >> 3) * 2) * 512 + (8 * ((v >> 2) & 1) + (v & 3)) * 32;
                yp[lo_y] = (bf16)f2bf_hw(y[0][v] * rstd * lon[0]); yp[lo_y + 512] = (bf16)f2bf_hw(y[1][v] * rstd * lon[1]); }
        }
        LDS_WAIT();
    }
    if constexpr (!FINAL) {
        if (hh == 0) {
#pragma unroll
            for (int nb = 0; nb < 2; ++nb) { float* ag = AGG + ((size_t)item * LW + chb + 32 * nb) * 2; f32x2 v2; v2.x = Arun[nb]; v2.y = Hrun[nb]; ((f32x2*)ag)[r] = v2; }
        }
    }
}

__device__ __forceinline__ void mixer1_phase(const Args& a, LAS unsigned char* lds, int l, int G, const int WV) {
    GET_TID(tid);
    const int h = WV;
    GAS unsigned char* wsg_ = (GAS unsigned char*)a.ws; asm volatile("" : "+s"(wsg_)); unsigned char* ws = (unsigned char*)wsg_;
    const bf16* PROJ = (const bf16*)(ws + WS_ACT);
    bf16* Y = (bf16*)(ws + WS_Y);
    const bf16* GWT = (const bf16*)(ws + WS_GWT); const bf16* SPWm = (const bf16*)(ws + WS_SPW);
    LAS unsigned char* wl = lds + h * M1_WAVE_LDS;
    LAS unsigned short* xcL = (LAS unsigned short*)wl;
    LAS float* xcF = (LAS float*)(wl + 4608);
    LAS unsigned short* vhT = (LAS unsigned short*)wl;
    LAS float* part = (LAS float*)(lds + M1_PART_OFF);
    for (int item = blockIdx.x; item < NB * 32; item += G) {
        const int c = item & 31; const size_t r0 = (size_t)item * 128;
        REPS(9) lru_pass<false>(a, lds, l, item, tid, h);
#ifndef M1_NO_GMLP
        {
            unsigned lane = tid & 63; asm volatile("" : "+v"(lane));
            const unsigned r = lane & 31, hh = lane >> 5;
            const bf16* Vu = PROJ + (size_t)(item >> 1) * (32 * 16384) + (size_t)(24 + h) * 16384 + (item & 1) * 8192;
            u32x4 vraw[2][8];
#pragma unroll
            for (int half = 0; half < 2; ++half) { const unsigned s_ = lane + 64 * half; const bf16* vp = Vu + ((s_ >> 4) * 2) * 512 + (s_ & 15) * 32;
#pragma unroll
                for (int i = 0; i < 8; ++i) vraw[half][i] = *(const u32x4*)(vp + (i >> 2) * 512 + (i & 3) * 8); }
#pragma unroll
            for (int half = 0; half < 2; ++half) {
                float vv[64]; float sum = 0.f;
#pragma unroll
                for (int i = 0; i < 8; ++i) { const u32x4 w = vraw[half][i];
#pragma unroll
                    for (int j = 0; j < 4; ++j) { const float lo = gelu_tanh(bf2f(w[j] & 0xffffu)), hi = gelu_tanh(__uint_as_float(w[j] & 0xffff0000u)); vv[8 * i + 2 * j] = lo; vv[8 * i + 2 * j + 1] = hi; sum += lo + hi; } }
                const float mean = sum * (1.f / 64.f); float q = 0.f;
#pragma unroll
                for (int d = 0; d < 64; ++d) { vv[d] -= mean; q += vv[d] * vv[d]; }
                const float rstd = __builtin_amdgcn_rsqf(q * (1.f / 64.f) + EPS);
                LAS unsigned short* vs = vhT + lane + 64 * half;
#pragma unroll
                for (int d = 0; d < 64; ++d) vs[d * 136] = (unsigned short)f2bf_hw(vv[d] * rstd);
            }
            LDS_WAIT();
            const bf16* Wm = SPWm + (size_t)(l * 8 + h) * 128 * 128;
            const float go0 = (AIN(I_GON) + l * LW + 64 * h)[r], go1 = (AIN(I_GON) + l * LW + 64 * h + 32)[r];
            const float vn0 = (AIN(I_VN) + l * LW + 64 * h)[r], vn1 = (AIN(I_VN) + l * LW + 64 * h + 32)[r];
#pragma unroll 1
            for (int mb = 0; mb < 4; ++mb) {
                unsigned ln = lane; asm volatile("" : "+v"(ln));
                const unsigned r_ = ln & 31, hh_ = ln >> 5;
                f32x16 acc0, acc1;
#pragma unroll
                for (int i = 0; i < 16; ++i) { acc0[i] = 0.f; acc1[i] = 0.f; }
                const bf16* urow = PROJ + (size_t)(item >> 1) * (32 * 16384) + (size_t)(16 + h) * 16384 + (item & 1) * 8192 + (4 * mb) * 512;
                const float* sbrow = AIN(I_SPB) + (l * 8 + h) * 128 + 32 * mb;
                const unsigned lo_u = hh_ * 128 + r_, lo_y = hh_ * 128 + r_;
                unsigned short uraw0[16], uraw1[16];
#pragma unroll
                for (int v = 0; v < 16; ++v) { const int tc = (v & 3) + 8 * (v >> 2); const bf16* up = urow + ((v >> 3) * 2) * 512 + (8 * ((v >> 2) & 1) + (v & 3)) * 32; uraw0[v] = up[lo_u]; uraw1[v] = up[lo_u + 512]; (void)tc; }
                { const bf16* wrow = Wm + (32 * mb) * 128; const unsigned wo = r_ * 128 + 8 * hh_; const LAS unsigned short* vb = vhT + r_ * 136 + 8 * hh_;
                  bf16x8 Afs[8];
#pragma unroll
                  for (int ks = 0; ks < 8; ++ks) Afs[ks] = *(const bf16x8*)(wrow + 16 * ks + wo);
#pragma unroll
                  for (int ks = 0; ks < 8; ++ks) {
                    const bf16x8 B0 = *(const LAS bf16x8*)(vb + 16 * ks);
                    const bf16x8 B1 = *(const LAS bf16x8*)(vb + 32 * 136 + 16 * ks);
                    acc0 = MFMA32(Afs[ks], B0, acc0); acc1 = MFMA32(Afs[ks], B1, acc1);
                  } }
                float y0[16], y1[16];
                const int pb = mb & 1;
                LAS float* pw = part + pb * 256 + hh_ * 32 + h;
#pragma unroll
                for (int v = 0; v < 16; ++v) { const int tc = (v & 3) + 8 * (v >> 2);
                    const float sb_lo = sbrow[tc], sb_hi = sbrow[tc + 4]; const float sbv = hh_ ? sb_hi : sb_lo;
                    const float u0 = gelu_tanh(bf2f(uraw0[v])), u1 = gelu_tanh(bf2f(uraw1[v]));
                    y0[v] = u0 * (acc0[v] * vn0 + sbv); y1[v] = u1 * (acc1[v] * vn1 + sbv);
                    float ss = y0[v] * y0[v] + y1[v] * y1[v];
                    ss += shx<1>(ss); ss += shx<2>(ss); ss += shx<4>(ss); ss += shx<8>(ss); ss += shx<16>(ss);
                    if (r_ == 0) pw[tc * 8] = ss; }
                LDS_WAIT(); __syncthreads();
                bf16* yrow = Y + (size_t)(item >> 1) * (256 * DM) + (size_t)(8 + h) * 16384 + (item & 1) * 8192 + (4 * mb) * 512;
                const LAS float* pr = part + pb * 256 + hh_ * 32;
#pragma unroll
                for (int v = 0; v < 16; ++v) { const int tc = (v & 3) + 8 * (v >> 2);
                    const f32x4 p0 = *(const LAS f32x4*)(pr + tc * 8), p1 = *(const LAS f32x4*)(pr + tc * 8 + 4);
                    const float tot = ((p0[0] + p0[1]) + (p0[2] + p0[3])) + ((p1[0] + p1[1]) + (p1[2] + p1[3]));
                    const float rstd = __builtin_amdgcn_rsqf(tot * (1.f / LW) + EPS);
                    bf16* yp = yrow + ((v >> 3) * 2) * 512 + (8 * ((v >> 2) & 1) + (v & 3)) * 32;
                    yp[lo_y] = (bf16)f2bf_hw(y0[v] * rstd * go0); yp[lo_y + 512] = (bf16)f2bf_hw(y1[v] * rstd * go1); }
            }
            LDS_WAIT();
        }
#endif
    }
}

__device__ __forceinline__ void mixer2_phase(const Args& a, LAS unsigned char* lds, int l, int G, const int WV) {
    GET_TID(tid);
    for (int item = blockIdx.x; item < NB * 32; item += G) { lru_pass<true>(a, lds, l, item, tid, WV); __syncthreads(); }
}

__global__ void __launch_bounds__(NWAVES * 64, 2) mk_fwd(Args args) {
    extern __shared__ __attribute__((aligned(16))) unsigned char lds_raw[];
    LAS unsigned char* lds = (LAS unsigned char*)lds_raw;
    cg::grid_group grid = cg::this_grid();
    const int WV = __builtin_amdgcn_readfirstlane(threadIdx.x >> 6);
#if MK_N_LAUNCHES == 1
    const int G = gridDim.x; constexpr int lo = 0, hi = 1 << 20;
#else
    const int G = gridDim.x, lo = args.lo, hi = args.hi;
#endif
    unsigned char* ws0 = args.ws;
    volatile LAS unsigned* bst = (volatile LAS unsigned*)(lds + LDS_MISC_OFF);
#define T0() (WV == 0 && lane_id_v() == 0)
    if (T0()) { bst[0] = 0u; bst[1] = 0u; }
    __syncthreads();
    XcdBarrier xbar = xcd_barrier_post((unsigned*)ws0, bst, T0());
    int ph = 0;
#define ACTIVE() (ph >= lo && ph < hi)
#define SEAM() do { if (ph >= lo && ph + 1 < hi) { if (args.hi == -12345) grid.sync();   else xcd_barrier(xbar, T0()); if (DUP_PHASE == 7) xcd_barrier(xbar, T0()); } ++ph; } while (0)

    #ifndef SKIP_P0
    if (ACTIVE()) REPS(1) { p0_phase(args, lds, G, WV); __syncthreads(); }
#endif
    SEAM();
#define WSPTRS() GAS unsigned char* wsg_ = (GAS unsigned char*)ws0; asm volatile("" : "+s"(wsg_)); unsigned char* ws = (unsigned char*)wsg_; _Float16* X = (_Float16*)(ws + WS_X16); const float* mod = (const float*)(ws + WS_MOD); bf16* H = (bf16*)(ws + WS_H); bf16* ACT = (bf16*)(ws + WS_ACT); \
    float* RSS = (float*)(ws + WS_RSS); const float* GSb = (const float*)(ws + WS_GS); const float* SWb = (const float*)(ws + WS_SW); bf16* Yb = (bf16*)(ws + WS_Y); \
    (void)X; (void)mod; (void)H; (void)ACT; (void)RSS; (void)GSb; (void)SWb; (void)Yb
    if (ACTIVE()) { WSPTRS(); REPS(2) norm0_phase(AIN(I_X), X, AIN(I_F1N), mod + DM, H, RSS, G, WV); REPS(10) prep_phase(args, lds, G, WV); }
    SEAM();
    for (int l = 0; l < DEPTH; ++l) {
        for (int sub = 0; sub < 3; ++sub) {
            int bid = blockIdx.x; asm volatile("" : "+s"(bid));
            WSPTRS();
            const float* modl = mod + (size_t)l * NB * NMOD;
            unsigned char* wl = ws + WS_W + (size_t)l * WL_SIZE;
            const int ls = l * 3 + sub;
            const float* rss_in = RSS + (size_t)ls * M; const float* sw_in = SWb + (size_t)ls * NB * 5632;
            if (sub != 1) {
                if (ACTIVE()) {
                    pg8::Gemm g{H, (const bf16*)(wl + (sub == 0 ? WL_GU1 : WL_GU2)), M, NGU, DM, true}; pg8::StaticOrder S; S.init(M, NGU, G, bid);
                    pg8::EpiSwiglu E{ACT, DFF, rss_in, sw_in};
                    REPS(3) pg8::gemm_phase<pg8::EpiSwiglu, pg8::StaticOrder, true, true>(lds, g, S, E, WV);
                }
                SEAM();
            } else {
                if (ACTIVE()) {
                    pg8::Gemm g{H, (const bf16*)(wl + WL_WIN), M, NIN, DM, true}; pg8::StaticOrder S; S.init(M, NIN, G, bid);
                    pg8::EpiBf16 E{ACT, NIN, rss_in, sw_in};
                    REPS(4) pg8::gemm_phase<pg8::EpiBf16, pg8::StaticOrder, true, true>(lds, g, S, E, WV);
                }
                SEAM();
                if (ACTIVE()) REPS(5) mixer1_phase(args, lds, l, G, WV);
                SEAM();
                if (ACTIVE()) REPS(6) mixer2_phase(args, lds, l, G, WV);
                SEAM();
            }
            if (ACTIVE()) {
                const bf16* Ain = (sub == 1) ? Yb : ACT; const int K = (sub == 1) ? DM : DFF;
                const bf16* Bt = (const bf16*)(wl + (sub == 0 ? WL_DOWN1 : sub == 1 ? WL_WOUT : WL_DOWN2));
                pg8::Gemm g{Ain, Bt, M, DM, K, true}; pg8::StaticOrder S; S.init(M, DM, G, bid);
                const int lsn = (ls + 1 < DEPTH * 3) ? ls + 1 : ls;
                pg8::EpiResid E{X, modl + (3 * sub + 2) * DM, H, GSb + (size_t)lsn * NB * DM, RSS + (size_t)(ls + 1) * M, (sub == 1 ? 1.0f : 0.5f), (ls + 1 < DEPTH * 3) ? 1 : 0};
                pg8::gemm_phase<pg8::EpiResid, pg8::StaticOrder, true, true>(lds, g, S, E, WV);
            }
            SEAM();
        }
    }
    if (ACTIVE()) { WSPTRS(); final_phase(X, args.out, AIN(I_FIN), RSS + (size_t)(DEPTH * 3) * M, G, WV); }
#undef ACTIVE
#undef SEAM
}
constexpr int N_PHASES = 2 + DEPTH * 8 + 1;

extern "C" void kernel_launch(void* const* d_in, const int* in_sizes, int n_in, void* d_out, int out_size, void* d_ws, size_t ws_size, hipStream_t stream) {
    static int grid = 0;
    if (grid == 0) {
        if (n_in != 26 || in_sizes[0] != M * DM || out_size != M * DM || ws_size < WS_END) { fprintf(stderr, "kernel_launch: unexpected shapes (n_in %d, in0 %d, out %d, ws %zu)\n", n_in, n_in > 0 ? in_sizes[0] : -1, out_size, ws_size); grid = -1; return; }
        int dev = 0, cus = 0, per_cu = 0;
        if (hipGetDevice(&dev) != hipSuccess || hipDeviceGetAttribute(&cus, hipDeviceAttributeMultiprocessorCount, dev) != hipSuccess) { grid = -1; return; }
        if (hipFuncSetAttribute((const void*)mk_fwd, hipFuncAttributeMaxDynamicSharedMemorySize, LDS_BYTES) != hipSuccess) { fprintf(stderr, "kernel_launch: hipFuncSetAttribute failed\n"); grid = -1; return; }
        if (hipOccupancyMaxActiveBlocksPerMultiprocessor(&per_cu, (const void*)mk_fwd, NWAVES * 64, LDS_BYTES) != hipSuccess || per_cu < 1) { fprintf(stderr, "kernel_launch: occupancy query says %d\n", per_cu); per_cu = 1; }
        (void)hipGetLastError();
        grid = cus * 1;
    }
    if (grid < 0) return;
    if (hipMemsetAsync(d_ws, 0, WS_ZERO_BYTES, stream) != hipSuccess) { fprintf(stderr, "kernel_launch: memset of the barrier words failed\n"); return; }
    Args a{};
    for (int i = 0; i < 26; ++i) a.in[i] = (const float*)d_in[i];
    a.out = (float*)d_out; a.ws = (unsigned char*)d_ws;
#if MK_N_LAUNCHES == 1
    a.lo = 0; a.hi = N_PHASES;
    void* kargs[] = {&a};
    hipError_t e = hipLaunchCooperativeKernel((const void*)mk_fwd, dim3(grid), dim3(NWAVES * 64), kargs, LDS_BYTES, stream);
    if (e != hipSuccess) fprintf(stderr, "kernel_launch: cooperative launch failed: %s (grid %d)\n", hipGetErrorString(e), grid);
#else
    for (int p = 0; p < N_PHASES; ++p) { a.lo = p; a.hi = p + 1; hipLaunchKernelGGL(mk_fwd, dim3(grid), dim3(NWAVES * 64), LDS_BYTES, stream, a); }
#endif
}
```
